# Optimizing an MI355X kernel written in HIP

```python
import jax
import jax.numpy as jnp
from jax import lax
import numpy as np

D_MODEL = 1024
BATCH = 4
SEQ = 8192
DEPTH = 2

GRID_W = 64
CTX_LEN = 256
EPS = 1e-6
N_MOD = 6

F_GROUPS = 4
F_GROUP_DIM = 64
F_WIDTH = F_GROUPS * F_GROUP_DIM
NA_HEADS = 8
NA_HEAD_DIM = 64
NA_WIDTH = NA_HEADS * NA_HEAD_DIM
WIN_H = 8
WIN_W = 16
Q_BLOCK = 16
KEY_SPAN = Q_BLOCK + WIN_W
CONV_GROUPS = 4
CONV_GROUP_DIM = 64
CONV_WIDTH = CONV_GROUPS * CONV_GROUP_DIM
CONV_K = 3
N_BRANCH = 3

Q_OFF = F_WIDTH
K_OFF = Q_OFF + NA_WIDTH
V_OFF = K_OFF + NA_WIDTH
U_OFF = V_OFF + NA_WIDTH
B_OFF = U_OFF + CONV_WIDTH
C_OFF = B_OFF + CONV_WIDTH
G_OFF = C_OFF + CONV_WIDTH
PROJ_WIDTH = G_OFF + N_BRANCH * D_MODEL
SPLITS = (Q_OFF, K_OFF, V_OFF, U_OFF, B_OFF, C_OFF, G_OFF)

D_FF = 2816
N_EXPERTS = 8
TOP_K = 2
D_FF_EXPERT = 3584
N_DENSE = (DEPTH + 1) // 2
N_MOE = DEPTH // 2

kernel_name = "hybrid_fnet_natten_shortconv_moe_dit"


def rmsnorm(x, g):
    xf = x.astype(jnp.float32)
    y = xf * lax.rsqrt(jnp.mean(xf * xf, axis=-1, keepdims=True) + EPS)
    return (y * g.astype(jnp.float32)).astype(x.dtype)


def modulate(h, shift, scale):
    return h * (1 + scale) + shift


def heads(t):
    return t.reshape(t.shape[0], t.shape[1], NA_HEADS, NA_HEAD_DIM)


def fourier_mix(u):
    b, l, _ = u.shape
    uf = u.astype(jnp.float32).reshape(b, l, F_GROUPS, F_GROUP_DIM)
    y = jnp.fft.fft2(uf, axes=(1, 3), norm="ortho").real
    return y.reshape(b, l, F_WIDTH).astype(u.dtype)


def short_conv(u, w):
    return lax.conv_general_dilated(
        u, w[:, None, :].astype(u.dtype), window_strides=(1,),
        padding=[(CONV_K // 2, CONV_K // 2)],
        dimension_numbers=("NWC", "WIO", "NWC"),
        feature_group_count=u.shape[-1])


def context_attention(q, k, v):
    s = jnp.einsum("blhd,bmhd->bhlm", q, k).astype(jnp.float32) * (NA_HEAD_DIM ** -0.5)
    p = jax.nn.softmax(s, axis=-1).astype(v.dtype)
    o = jnp.einsum("bhlm,bmhd->blhd", p, v)
    return o.reshape(o.shape[0], o.shape[1], NA_WIDTH)


def neighbourhood_attention(q, k, v, k_ctx, v_ctx, rpb):
    b, s_len, h, dh = q.shape
    rows = s_len // GRID_W
    kh = min(WIN_H, rows)
    qg = q.reshape(b, rows, GRID_W, h, dh)
    kg = k.reshape(b, rows, GRID_W, h, dh)
    vg = v.reshape(b, rows, GRID_W, h, dh)
    r = jnp.arange(rows)
    row_idx = jnp.clip(r - kh // 2, 0, rows - kh)[:, None] + jnp.arange(kh)[None, :]
    k_rows = kg[:, row_idx]
    v_rows = vg[:, row_idx]
    dr = row_idx - r[:, None] + (WIN_H - 1)
    col_start = np.clip(np.arange(GRID_W) - WIN_W // 2, 0, GRID_W - WIN_W)
    scale = NA_HEAD_DIM ** -0.5
    n_win = kh * KEY_SPAN
    outs = []
    for a in range(0, GRID_W, Q_BLOCK):
        s0 = min(max(a - WIN_W // 2, 0), GRID_W - KEY_SPAN)
        qc = np.arange(a, a + Q_BLOCK)
        kc = np.arange(s0, s0 + KEY_SPAN)
        cs = col_start[qc][:, None]
        in_win = (kc[None, :] >= cs) & (kc[None, :] < cs + WIN_W)
        dc = np.clip(kc[None, :] - qc[:, None] + (WIN_W - 1), 0, 2 * WIN_W - 2)
        qb = qg[:, :, a:a + Q_BLOCK]
        kb = k_rows[:, :, :, s0:s0 + KEY_SPAN]
        vb = v_rows[:, :, :, s0:s0 + KEY_SPAN]
        s_win = jnp.einsum("brqhd,brkwhd->bhrqkw", qb, kb).astype(jnp.float32) * scale
        bias = rpb[:, dr[:, None, :, None], dc[None, :, None, :]]
        s_win = s_win + bias.astype(jnp.float32)[None]
        s_win = jnp.where(in_win[:, None, :], s_win, -jnp.inf)
        s_ctx = jnp.einsum("brqhd,blhd->bhrql", qb, k_ctx).astype(jnp.float32) * scale
        s_all = jnp.concatenate([s_win.reshape(b, h, rows, Q_BLOCK, n_win), s_ctx], axis=-1)
        p = jax.nn.softmax(s_all, axis=-1).astype(v.dtype)
        p_win = p[..., :n_win].reshape(b, h, rows, Q_BLOCK, kh, KEY_SPAN)
        p_ctx = p[..., n_win:]
        o = (jnp.einsum("bhrqkw,brkwhd->brqhd", p_win, vb)
             + jnp.einsum("bhrql,blhd->brqhd", p_ctx, v_ctx))
        outs.append(o)
    out = jnp.concatenate(outs, axis=2)
    return out.reshape(b, s_len, NA_WIDTH)


def merge_branches(zf, zu, zb, zc, zg, attn, conv_w, w_fourier, w_na, w_conv_out, w_out):
    y_f = fourier_mix(zf) @ w_fourier
    y_a = attn @ w_na
    y_c = (zb * short_conv(zc * zu, conv_w)) @ w_conv_out
    g_f, g_a, g_c = jnp.split(jax.nn.sigmoid(zg), N_BRANCH, axis=-1)
    return (g_f * y_f + g_a * y_a + g_c * y_c) @ w_out


def swiglu(h, w_gate, w_up, w_down):
    return (jax.nn.silu(h @ w_gate) * (h @ w_up)) @ w_down


def moe(h, w_router, w_gate, w_up, w_down):
    logits = (h @ w_router).astype(jnp.float32)
    top_val, top_idx = lax.top_k(logits, TOP_K)
    top_w = jax.nn.softmax(top_val, axis=-1)
    gates = jnp.sum(jax.nn.one_hot(top_idx, N_EXPERTS, dtype=jnp.float32) * top_w[..., None],
                    axis=-2).astype(h.dtype)
    out = jnp.zeros_like(h)
    for e in range(N_EXPERTS):
        out = out + gates[..., e:e + 1] * swiglu(h, w_gate[e], w_up[e], w_down[e])
    return out


def setup_inputs(seed: int = 0) -> dict:
    key = jax.random.key(seed)
    ks = jax.random.split(key, 24)
    f32 = jnp.float32
    D = D_MODEL

    def nrm(k, shape, scale):
        return jax.random.normal(k, shape, f32) * scale

    return {
        "x": nrm(ks[0], (BATCH, SEQ, D), 1.0),
        "c": nrm(ks[1], (BATCH, D), 1.0),
        "ctx": nrm(ks[2], (BATCH, CTX_LEN, D), 1.0),
        "c_ctx": nrm(ks[3], (D,), 1.0),
        "norm1_g": 1.0 + nrm(ks[4], (DEPTH, D), 0.1),
        "norm2_g": 1.0 + nrm(ks[5], (DEPTH, D), 0.1),
        "w_ada": nrm(ks[6], (DEPTH, D, N_MOD * D), 0.5 * D ** -0.5),
        "b_ada": nrm(ks[7], (DEPTH, N_MOD * D), 0.01),
        "w_in": nrm(ks[8], (DEPTH, D, PROJ_WIDTH), D ** -0.5),
        "conv_w": nrm(ks[9], (DEPTH, CONV_K, CONV_WIDTH), CONV_K ** -0.5),
        "na_rpb": nrm(ks[10], (DEPTH, NA_HEADS, 2 * WIN_H - 1, 2 * WIN_W - 1), 0.1),
        "w_fourier": nrm(ks[11], (DEPTH, F_WIDTH, D), F_WIDTH ** -0.5),
        "w_na": nrm(ks[12], (DEPTH, NA_WIDTH, D), NA_WIDTH ** -0.5),
        "w_conv_out": nrm(ks[13], (DEPTH, CONV_WIDTH, D), CONV_WIDTH ** -0.5),
        "w_out": nrm(ks[14], (DEPTH, D, D), D ** -0.5),
        "ffn_w_gate": nrm(ks[15], (N_DENSE, D, D_FF), D ** -0.5),
        "ffn_w_up": nrm(ks[16], (N_DENSE, D, D_FF), D ** -0.5),
        "ffn_w_down": nrm(ks[17], (N_DENSE, D_FF, D), D_FF ** -0.5),
        "moe_router": nrm(ks[18], (N_MOE, D, N_EXPERTS), D ** -0.5),
        "moe_w_gate": nrm(ks[19], (N_MOE, N_EXPERTS, D, D_FF_EXPERT), D ** -0.5),
        "moe_w_up": nrm(ks[20], (N_MOE, N_EXPERTS, D, D_FF_EXPERT), D ** -0.5),
        "moe_w_down": nrm(ks[21], (N_MOE, N_EXPERTS, D_FF_EXPERT, D), D_FF_EXPERT ** -0.5),
        "final_g": 1.0 + nrm(ks[22], (D,), 0.1),
    }


def reference(x, c, ctx, c_ctx, norm1_g, norm2_g, w_ada, b_ada, w_in, conv_w, na_rpb,
              w_fourier, w_na, w_conv_out, w_out, ffn_w_gate, ffn_w_up, ffn_w_down,
              moe_router, moe_w_gate, moe_w_up, moe_w_down, final_g):
    def channel_mixer(l, h):
        if l % 2 == 0:
            j = l // 2
            return swiglu(h, ffn_w_gate[j], ffn_w_up[j], ffn_w_down[j])
        j = l // 2
        return moe(h, moe_router[j], moe_w_gate[j], moe_w_up[j], moe_w_down[j])

    for l in range(DEPTH):
        last = l == DEPTH - 1
        mod_x = [m[:, None, :] for m in jnp.split(jax.nn.silu(c) @ w_ada[l] + b_ada[l], N_MOD, axis=-1)]
        mod_c = jnp.split(jax.nn.silu(c_ctx) @ w_ada[l] + b_ada[l], N_MOD, axis=-1)

        hx = modulate(rmsnorm(x, norm1_g[l]), mod_x[0], mod_x[1])
        hc = modulate(rmsnorm(ctx, norm1_g[l]), mod_c[0], mod_c[1])
        zf, zq, zk, zv, zu, zb, zcg, zg = jnp.split(hx @ w_in[l], SPLITS, axis=-1)

        if last:
            k_c, v_c = jnp.split(hc @ w_in[l][:, K_OFF:U_OFF], 2, axis=-1)
            k_c, v_c = heads(k_c), heads(v_c)
        else:
            cf, cq, ck, cv, cu, cb, ccg, cg = jnp.split(hc @ w_in[l], SPLITS, axis=-1)
            k_c, v_c = heads(ck), heads(cv)
            attn_c = context_attention(heads(cq), k_c, v_c)
            mix_c = merge_branches(cf, cu, cb, ccg, cg, attn_c, conv_w[l],
                                   w_fourier[l], w_na[l], w_conv_out[l], w_out[l])
            ctx_mid = ctx + mod_c[2] * mix_c
            hc2 = modulate(rmsnorm(ctx_mid, norm2_g[l]), mod_c[3], mod_c[4])
            ctx = ctx_mid + mod_c[5] * channel_mixer(l, hc2)

        attn_x = neighbourhood_attention(heads(zq), heads(zk), heads(zv), k_c, v_c, na_rpb[l])
        mix_x = merge_branches(zf, zu, zb, zcg, zg, attn_x, conv_w[l],
                               w_fourier[l], w_na[l], w_conv_out[l], w_out[l])
        x = x + mod_x[2] * mix_x

        hx2 = modulate(rmsnorm(x, norm2_g[l]), mod_x[3], mod_x[4])
        x = x + mod_x[5] * channel_mixer(l, hx2)

    return rmsnorm(x, final_g)
```

```cpp
#include <hip/hip_runtime.h>
#include <cstdio>
#include <cstdint>

#define LAS __attribute__((address_space(3)))
#define GAS __attribute__((address_space(1)))
typedef unsigned short bf16;
typedef short bf16x8 __attribute__((ext_vector_type(8)));
typedef float f32x4 __attribute__((ext_vector_type(4)));
typedef float f32x2 __attribute__((ext_vector_type(2)));
typedef unsigned u32x4 __attribute__((ext_vector_type(4)));
typedef unsigned u32x2 __attribute__((ext_vector_type(2)));
typedef __bf16 bf16x2_t __attribute__((ext_vector_type(2)));

constexpr int D = 1024, BATCH = 4, SEQ = 8192, CTXL = 256;
constexpr int ML = BATCH * SEQ, MC = BATCH * CTXL, MT = ML + MC;
constexpr int PW = 5632, Q_OFF = 256, K_OFF = 768, V_OFF = 1280, U_OFF = 1792, B_OFF = 2048, C_OFF = 2304, G_OFF = 2560;
constexpr int DFF = 2816, DFE = 3584, NE = 8;
constexpr int VT_LD = SEQ + CTXL;
constexpr int NMOD = 6 * D;
constexpr float EPS = 1e-6f;
constexpr int MOE_CHUNK = 64;

constexpr size_t MiB = 1u << 20;
constexpr size_t WS_CTL = 0, CTL_ZERO_BYTES = 1 * MiB;
constexpr size_t WS_MOD = 1 * MiB;
constexpr size_t WS_ROUTE = 1 * MiB + 256 * 1024;
constexpr size_t WS_CP = 2 * MiB;
constexpr size_t WS_XC = 4 * MiB;
constexpr size_t WS_WIN = 8 * MiB;
constexpr size_t WS_WCAT = 30 * MiB;
constexpr size_t WS_WOUT = 34 * MiB;
constexpr size_t WS_WGU0 = 38 * MiB;
constexpr size_t WS_WD0 = 49 * MiB;
constexpr size_t WS_HX = 55 * MiB;
constexpr size_t WS_Z = 121 * MiB;
constexpr size_t WS_VT = 484 * MiB;
constexpr size_t WS_R = 517 * MiB;
constexpr size_t WS_END = 549 * MiB;
constexpr size_t WS_G = WS_Z;
constexpr size_t WS_WMGU = 121 * MiB;
constexpr size_t WS_WMD = 233 * MiB;
constexpr size_t WS_H = 289 * MiB;
constexpr size_t WS_XY = 401 * MiB;
static_assert(WS_XY + (size_t)67584 * 1024 * 2 <= WS_END && WS_H + (size_t)16384 * 3584 * 2 <= WS_XY && WS_G + (size_t)MT * DFF * 2 <= WS_VT, "ws map");
constexpr int CW_TMO = 0, CW_BAR = 4096, CW_CNT = 8192;

constexpr int RING_BYTES = 131072, LDSCTL_OFF = RING_BYTES, MISC_OFF = LDSCTL_OFF + 320, LDS_BYTES = 147456;
constexpr int NWAVES = 8;

__device__ __forceinline__ int fresh_s(int v) { asm volatile("" : "+s"(v)); return v; }
__device__ __forceinline__ int fresh_tid() { int t = threadIdx.x; asm volatile("" : "+v"(t)); return t; }
__device__ __forceinline__ unsigned pk2(float lo, float hi) { f32x2 v = {lo, hi}; bf16x2_t b = __builtin_convertvector(v, bf16x2_t); return __builtin_bit_cast(unsigned, b); }
__device__ __forceinline__ float bflo(unsigned w) { return __uint_as_float(w << 16); }
__device__ __forceinline__ float bfhi(unsigned w) { return __uint_as_float(w & 0xffff0000u); }
__device__ __forceinline__ float bf2f(bf16 b) { return __uint_as_float(((unsigned)b) << 16); }
__device__ __forceinline__ float fast_exp2(float x) { return __builtin_amdgcn_exp2f(x); }
__device__ __forceinline__ float sigmoidf_(float x) { return 1.0f / (1.0f + __expf(-x)); }

namespace pg8 {
constexpr int BM = 256, BK = 64, HALF = 128, HTB = HALF * BK * 2, STAGE_BYTES = 8 * HTB, NXCD = 8, WGM = 8;
__host__ __device__ __forceinline__ int lds_byte(int r, int c) { const int st = (r >> 4) * 2 + (c >> 5), rr = r & 15, cc = c & 31, ob = rr * 64 + cc * 2; return st * 1024 + (ob ^ (((ob >> 9) & 1) << 5)); }
__host__ __device__ __forceinline__ void stage_rc(int b, int& R, int& C) { const int st = b / 1024, sb = b % 1024, swz = sb ^ (((sb >> 9) & 1) << 5); R = (st >> 1) * 16 + swz / 64; C = (st & 1) * 32 + (swz % 64) / 2; }
__host__ __device__ __forceinline__ int perm32(int rho) { const int n = rho >> 4, i = rho & 15; return 8 * (i >> 2) + 4 * n + (i & 3); }

struct Unit { int pm, pn; const char* A; const char* B; int nt; int aux; };
struct Gemm { int lda, ldb; };

__device__ __forceinline__ bool tile_map(long L, int nM, int nN, int& pm, int& pn) {
    const int nwg = nM * nN; if (L >= nwg) return false;
    int wgid = (int)L; { const int q = nwg / NXCD, r = nwg % NXCD, xcd = wgid % NXCD, off = wgid / NXCD; wgid = (xcd < r ? xcd * (q + 1) : r * (q + 1) + (xcd - r) * q) + off; }
    const int nig = WGM * nN, gid = wgid / nig, fm = gid * WGM, gsz = (nM - fm) < WGM ? (nM - fm) : WGM;
    pm = fm + ((wgid % nig) % gsz); pn = (wgid % nig) / gsz; return true;
}

template <class Epi, class Sched, bool ALIGN_EPI = true, bool SP2 = true>
__device__ __forceinline__ void gemm_phase(LAS unsigned char* lds, const Gemm g, const Sched& S, const Epi& E) {
    const int tid = fresh_tid(), wid = __builtin_amdgcn_readfirstlane(tid >> 6), lane = tid & 63, wr = wid >> 2, wc = wid & 3, fr = lane & 15, fq = lane >> 4;
    unsigned voffA[2], voffB[2];
#pragma unroll
    for (int i = 0; i < 2; ++i) { int R, C; stage_rc(tid * 16 + i * 8192, R, C); const int Rb = Epi::PERM ? ((R & ~31) + perm32(R & 31)) : R;
        voffA[i] = (unsigned)(R * g.lda + C) * 2u; voffB[i] = (unsigned)(Rb * g.ldb + C) * 2u; }
    const size_t kstep = (size_t)(BK * 2);
    const size_t hstepA = (size_t)HALF * g.lda * 2, hstepB = (size_t)HALF * g.ldb * 2;
    const unsigned ldsw = (unsigned)wid * 1024u;
    const int aoff = lds_byte(wr * 64 + fr, fq * 8), boff = lds_byte(wc * 32 + fr, fq * 8);
#define PG8_SA(b, h) (((b) * 2 + (h)) * HTB)
#define PG8_SB(b, h) ((4 + (b) * 2 + (h)) * HTB)
#define PG8_STAGE(bufoff, gbase, voff) do { _Pragma("unroll") for (int _i = 0; _i < 2; ++_i) \
        __builtin_amdgcn_global_load_lds((const unsigned*)((const char*)(gbase) + (voff)[_i]), (LAS unsigned*)(lds + (bufoff) + ldsw + _i * 8192), 16, 0, 0); } while (0)
#define PG8_LDA(dst, b, h) do { _Pragma("unroll") for (int m = 0; m < 4; ++m) _Pragma("unroll") for (int k = 0; k < 2; ++k) dst[m][k] = *(const LAS bf16x8*)(lds + PG8_SA(b, h) + aoff + m * 2048 + k * 1024); } while (0)
#define PG8_LDB(dst, b, h) do { _Pragma("unroll") for (int n = 0; n < 2; ++n) _Pragma("unroll") for (int k = 0; k < 2; ++k) dst[n][k] = *(const LAS bf16x8*)(lds + PG8_SB(b, h) + boff + n * 2048 + k * 1024); } while (0)
#define PG8_MMA(ai, bj, At, Bt) do { __builtin_amdgcn_s_setprio(1); _Pragma("unroll") for (int m = 0; m < 4; ++m) _Pragma("unroll") for (int n = 0; n < 2; ++n) _Pragma("unroll") for (int k = 0; k < 2; ++k) \
        acc[ai][bj][m][n] = __builtin_amdgcn_mfma_f32_16x16x32_bf16(Bt[n][k], At[m][k], acc[ai][bj][m][n], 0, 0, 0); __builtin_amdgcn_s_setprio(0); } while (0)
#define PG8_WAIT_V(n) asm volatile("s_waitcnt vmcnt(" #n ")" ::: "memory")
#define PG8_WAIT_L(n) asm volatile("s_waitcnt lgkmcnt(" #n ")" ::: "memory")
#define PG8_BAR __builtin_amdgcn_s_barrier()
#define PG8_SCHED __builtin_amdgcn_sched_barrier(0)
    Unit cur, nxt; int ui = 0;
    if (!S.next(0, cur)) return;
    f32x4 acc[2][2][4][2];
#pragma unroll
    for (int a = 0; a < 2; ++a)
#pragma unroll
        for (int b = 0; b < 2; ++b)
#pragma unroll
            for (int m = 0; m < 4; ++m)
#pragma unroll
                for (int n = 0; n < 2; ++n) acc[a][b][m][n] = (f32x4){0.f, 0.f, 0.f, 0.f};
    bf16x8 At[4][2], B0[2][2], B1[2][2];
    const char* cA = cur.A; const char* cB = cur.B;
    if constexpr (SP2) {
        PG8_STAGE(PG8_SB(0, 0), cB, voffB); PG8_STAGE(PG8_SB(0, 1), cB + hstepB, voffB); PG8_STAGE(PG8_SA(0, 0), cA, voffA); PG8_STAGE(PG8_SA(0, 1), cA + hstepA, voffA);
        if (wr == 1) PG8_BAR;
        PG8_WAIT_V(2); PG8_BAR;
        PG8_STAGE(PG8_SB(1, 0), cB + kstep, voffB); PG8_STAGE(PG8_SA(1, 0), cA + kstep, voffA); PG8_STAGE(PG8_SB(1, 1), cB + hstepB + kstep, voffB);
        PG8_WAIT_V(6); PG8_BAR;
    } else {
        PG8_STAGE(PG8_SB(0, 0), cB, voffB); PG8_STAGE(PG8_SA(0, 0), cA, voffA); PG8_STAGE(PG8_SB(0, 1), cB + hstepB, voffB); PG8_STAGE(PG8_SA(0, 1), cA + hstepA, voffA);
        if (wr == 1) PG8_BAR;
        PG8_WAIT_V(4); PG8_BAR;
        PG8_STAGE(PG8_SB(1, 0), cB + kstep, voffB); PG8_STAGE(PG8_SA(1, 0), cA + kstep, voffA); PG8_STAGE(PG8_SB(1, 1), cB + hstepB + kstep, voffB);
        PG8_WAIT_V(6); PG8_BAR;
    }
    for (;;) {
        const bool has_next = S.next(ui + 1, nxt);
        const char* nA = has_next ? nxt.A : cA; const char* nB = has_next ? nxt.B : cB;
        const int nt = cur.nt;
        for (int t = 0; t < nt; t += 2) {
            const bool last = (t == nt - 2);
            const char* a1 = cA + (size_t)(t + 1) * kstep;
            const char* a2 = last ? nA : cA + (size_t)(t + 2) * kstep; const char* b2 = last ? nB : cB + (size_t)(t + 2) * kstep;
            const char* a3 = a2 + kstep; const char* b3 = b2 + kstep;
            if constexpr (SP2) {
            PG8_LDB(B0, 0, 0); PG8_LDB(B1, 0, 1); PG8_SCHED; PG8_LDA(At, 0, 0); PG8_STAGE(PG8_SA(1, 1), a1 + hstepA, voffA);
            PG8_WAIT_V(8); PG8_WAIT_L(0); PG8_BAR; PG8_MMA(0, 0, At, B0); PG8_MMA(0, 1, At, B1); PG8_BAR; PG8_SCHED;
            PG8_LDA(At, 0, 1); PG8_STAGE(PG8_SB(0, 0), b2, voffB); PG8_STAGE(PG8_SB(0, 1), b2 + hstepB, voffB); PG8_STAGE(PG8_SA(0, 0), a2, voffA);
            PG8_WAIT_V(8); PG8_WAIT_L(0); PG8_BAR; PG8_MMA(1, 0, At, B0); PG8_MMA(1, 1, At, B1); PG8_BAR; PG8_SCHED;
            PG8_LDB(B0, 1, 0); PG8_LDB(B1, 1, 1); PG8_SCHED; PG8_LDA(At, 1, 0); PG8_STAGE(PG8_SA(0, 1), a2 + hstepA, voffA);
            PG8_WAIT_V(8); PG8_WAIT_L(0); PG8_BAR; PG8_MMA(0, 0, At, B0); PG8_MMA(0, 1, At, B1); PG8_BAR; PG8_SCHED;
            PG8_LDA(At, 1, 1); PG8_STAGE(PG8_SB(1, 0), b3, voffB); PG8_STAGE(PG8_SB(1, 1), b3 + hstepB, voffB); PG8_STAGE(PG8_SA(1, 0), a3, voffA);
            PG8_WAIT_V(8); PG8_WAIT_L(0); PG8_BAR; PG8_MMA(1, 0, At, B0); PG8_MMA(1, 1, At, B1); PG8_BAR; PG8_SCHED;
            } else {
            PG8_LDB(B0, 0, 0); PG8_SCHED; PG8_LDA(At, 0, 0); PG8_STAGE(PG8_SA(1, 1), a1 + hstepA, voffA);
            PG8_WAIT_L(8); PG8_BAR; PG8_WAIT_L(0); PG8_MMA(0, 0, At, B0); PG8_BAR; PG8_SCHED;
            PG8_LDB(B1, 0, 1); PG8_STAGE(PG8_SB(0, 0), b2, voffB);
            PG8_BAR; PG8_WAIT_L(0); PG8_MMA(0, 1, At, B1); PG8_BAR;
            PG8_LDA(At, 0, 1); PG8_STAGE(PG8_SA(0, 0), a2, voffA);
            PG8_BAR; PG8_WAIT_L(0); PG8_MMA(1, 0, At, B0); PG8_BAR; PG8_SCHED;
            PG8_STAGE(PG8_SB(0, 1), b2 + hstepB, voffB);
            PG8_WAIT_V(6); PG8_BAR; PG8_MMA(1, 1, At, B1); PG8_BAR;
            PG8_LDB(B0, 1, 0); PG8_SCHED; PG8_LDA(At, 1, 0); PG8_STAGE(PG8_SA(0, 1), a2 + hstepA, voffA);
            PG8_WAIT_L(8); PG8_BAR; PG8_WAIT_L(0); PG8_MMA(0, 0, At, B0); PG8_BAR; PG8_SCHED;
            PG8_LDB(B1, 1, 1); PG8_STAGE(PG8_SB(1, 0), b3, voffB);
            PG8_BAR; PG8_WAIT_L(0); PG8_MMA(0, 1, At, B1); PG8_BAR;
            PG8_LDA(At, 1, 1); PG8_STAGE(PG8_SA(1, 0), a3, voffA);
            PG8_BAR; PG8_WAIT_L(0); PG8_MMA(1, 0, At, B0); PG8_BAR; PG8_SCHED;
            PG8_STAGE(PG8_SB(1, 1), b3 + hstepB, voffB);
            PG8_WAIT_V(6); PG8_BAR; PG8_MMA(1, 1, At, B1); PG8_BAR;
            }
        }
        if constexpr (ALIGN_EPI) { if (wr == 0) PG8_BAR; }
        E(acc, cur, wr, wc, fr, fq);
        if (!has_next) break;
        if (E.zero_after(cur)) {
#pragma unroll
            for (int a = 0; a < 2; ++a)
#pragma unroll
                for (int b = 0; b < 2; ++b)
#pragma unroll
                    for (int m = 0; m < 4; ++m)
#pragma unroll
                        for (int n = 0; n < 2; ++n) acc[a][b][m][n] = (f32x4){0.f, 0.f, 0.f, 0.f};
        }
        cur = nxt; cA = nA; cB = nB; ++ui;
        if constexpr (ALIGN_EPI) { if (wr == 1) PG8_BAR; }
    }
    PG8_WAIT_V(0);
    if constexpr (!ALIGN_EPI) { if (wr == 0) PG8_BAR; }
    PG8_BAR;
#undef PG8_SA
#undef PG8_SB
#undef PG8_STAGE
#undef PG8_LDA
#undef PG8_LDB
#undef PG8_MMA
#undef PG8_WAIT_V
#undef PG8_WAIT_L
#undef PG8_BAR
#undef PG8_SCHED
}

struct SchedPlain {
    int nM, nN, G, c, nt; const char* A; const char* B; size_t tsA, tsB;
    __device__ __forceinline__ void init(int M, int N, int K, const bf16* A_, int lda, const bf16* B_, int ldb, int G_, int c_) {
        nM = M / BM; nN = N / BM; G = G_; c = c_; nt = K / BK; A = (const char*)A_; B = (const char*)B_; tsA = (size_t)BM * lda * 2; tsB = (size_t)BM * ldb * 2; }
    __device__ __forceinline__ bool next(int i, Unit& u) const {
        if (!tile_map((long)i * G + c, nM, nN, u.pm, u.pn)) return false;
        u.A = A + (size_t)u.pm * tsA; u.B = B + (size_t)u.pn * tsB; u.nt = nt; u.aux = 0; return true; }
};
struct SchedMerge {
    int nM, G, c; const char* Z; const char* W;
    __device__ __forceinline__ bool next(int i, Unit& u) const {
        const int ii = i / 3, br = i - 3 * ii;
        if (!tile_map((long)ii * G + c, nM, 4, u.pm, u.pn)) return false;
        const int acol = br == 0 ? 0 : (br == 1 ? Q_OFF : B_OFF), kof = br == 0 ? 0 : (br == 1 ? 256 : 768);
        u.A = Z + ((size_t)u.pm * BM * PW + acol) * 2; u.B = W + ((size_t)u.pn * BM * D + kof) * 2; u.nt = br == 1 ? 8 : 4; u.aux = br; return true; }
};
struct MoeTiles { int pre[NE + 1]; };
__device__ __forceinline__ int moe_expert(const MoeTiles& T, int tile) { int e = 0;
#pragma unroll
    for (int j = 1; j < NE; ++j) e += (tile >= T.pre[j]) ? 1 : 0; return e; }
struct SchedMoeUp {
    MoeTiles T; int t0, ntc, G, c; const char* X; const char* W;
    __device__ __forceinline__ bool next(int i, Unit& u) const {
        int pml; if (!tile_map((long)i * G + c, ntc, 28, pml, u.pn)) return false;
        const int tile = t0 + pml, e = moe_expert(T, tile);
        u.pm = pml; u.A = X + (size_t)tile * BM * D * 2; u.B = W + ((size_t)e * 7168 + (size_t)u.pn * BM) * D * 2; u.nt = 16; u.aux = 0; return true; }
};
struct SchedMoeDown {
    MoeTiles T; int t0, ntc, G, c; const char* H; const char* W;
    __device__ __forceinline__ bool next(int i, Unit& u) const {
        int pml; if (!tile_map((long)i * G + c, ntc, 4, pml, u.pn)) return false;
        const int tile = t0 + pml, e = moe_expert(T, tile);
        u.pm = tile; u.A = H + (size_t)pml * BM * DFE * 2; u.B = W + ((size_t)e * D + (size_t)u.pn * BM) * DFE * 2; u.nt = 56; u.aux = 0; return true; }
};

struct EpiInProj {
    static constexpr bool PERM = true;
    bf16* Z; bf16* VT;
    __device__ __forceinline__ bool zero_after(const Unit&) const { return true; }
    __device__ __forceinline__ void operator()(f32x4 (&acc)[2][2][4][2], const Unit& u, int wr, int wc, int fr, int fq) const {
        const int row0 = u.pm * BM + wr * 64 + fr, col0 = u.pn * BM + wc * 32 + 8 * fq;
        const int kind = (u.pn == 1 || u.pn == 2) ? 1 : ((u.pn == 5 || u.pn == 6) ? 2 : (u.pn >= 10 ? 3 : 0));
        if (kind == 2) {
#pragma unroll
            for (int ai = 0; ai < 2; ++ai)
#pragma unroll
                for (int m = 0; m < 4; ++m) { const int row = row0 + ai * HALF + m * 16;
                    const int b = row < ML ? (row >> 13) : ((row - ML) >> 8), t = row < ML ? (row & 8191) : (SEQ + ((row - ML) & 255));
#pragma unroll
                    for (int bj = 0; bj < 2; ++bj)
#pragma unroll
                        for (int n = 0; n < 2; ++n)
#pragma unroll
                            for (int j = 0; j < 4; ++j) { const int vc = col0 + bj * HALF + 4 * n + j - V_OFF;
                                VT[((size_t)(b * 512 + vc)) * VT_LD + t] = (bf16)(pk2(acc[ai][bj][m][n][j], 0.f) & 0xffffu); } }
            return;
        }
        const float qs = 0.125f * 1.44269504088896f;
#pragma unroll
        for (int ai = 0; ai < 2; ++ai)
#pragma unroll
            for (int m = 0; m < 4; ++m) { bf16* rowp = Z + (size_t)(row0 + ai * HALF + m * 16) * PW + col0;
#pragma unroll
                for (int bj = 0; bj < 2; ++bj) { f32x4 v0 = acc[ai][bj][m][0], v1 = acc[ai][bj][m][1];
                    if (kind == 1) { v0 = v0 * qs; v1 = v1 * qs; }
                    if (kind == 3) {
#pragma unroll
                        for (int j = 0; j < 4; ++j) { v0[j] = sigmoidf_(v0[j]); v1[j] = sigmoidf_(v1[j]); } }
                    u32x4 w; w.x = pk2(v0[0], v0[1]); w.y = pk2(v0[2], v0[3]); w.z = pk2(v1[0], v1[1]); w.w = pk2(v1[2], v1[3]);
                    *(u32x4*)(rowp + bj * HALF) = w; } }
    }
};
struct EpiMerge {
    static constexpr bool PERM = true;
    const bf16* Z; bf16* O;
    __device__ __forceinline__ bool zero_after(const Unit& u) const { return u.aux == 2; }
    __device__ __forceinline__ void operator()(f32x4 (&acc)[2][2][4][2], const Unit& u, int wr, int wc, int fr, int fq) const {
        const int row0 = u.pm * BM + wr * 64 + fr, col0 = u.pn * BM + wc * 32 + 8 * fq, br = u.aux;
#pragma unroll
        for (int ai = 0; ai < 2; ++ai)
#pragma unroll
            for (int m = 0; m < 4; ++m) { const size_t row = (size_t)(row0 + ai * HALF + m * 16);
#pragma unroll
                for (int bj = 0; bj < 2; ++bj) { const int col = col0 + bj * HALF;
                    const u32x4 gc = *(const u32x4*)(Z + row * PW + G_OFF + br * D + col);
                    float f[8] = {bflo(gc.x), bfhi(gc.x), bflo(gc.y), bfhi(gc.y), bflo(gc.z), bfhi(gc.z), bflo(gc.w), bfhi(gc.w)};
                    if (br < 2) { const u32x4 gn = *(const u32x4*)(Z + row * PW + G_OFF + (br + 1) * D + col);
                        const float d[8] = {bflo(gn.x), bfhi(gn.x), bflo(gn.y), bfhi(gn.y), bflo(gn.z), bfhi(gn.z), bflo(gn.w), bfhi(gn.w)};
#pragma unroll
                        for (int j = 0; j < 8; ++j) f[j] = f[j] / fmaxf(d[j], 1e-30f); }
#pragma unroll
                    for (int j = 0; j < 4; ++j) { acc[ai][bj][m][0][j] *= f[j]; acc[ai][bj][m][1][j] *= f[4 + j]; }
                    if (br == 2) { const f32x4 v0 = acc[ai][bj][m][0], v1 = acc[ai][bj][m][1];
                        u32x4 w; w.x = pk2(v0[0], v0[1]); w.y = pk2(v0[2], v0[3]); w.z = pk2(v1[0], v1[1]); w.w = pk2(v1[2], v1[3]);
                        *(u32x4*)(O + row * D + col) = w; } } }
    }
};
struct EpiResid {
    static constexpr bool PERM = false;
    const float* xl_in; const float* xc_in; float* xl_out; float* xc_out; const float* gate;
    __device__ __forceinline__ bool zero_after(const Unit&) const { return true; }
    __device__ __forceinline__ void operator()(f32x4 (&acc)[2][2][4][2], const Unit& u, int wr, int wc, int fr, int fq) const {
        const int rt = u.pm * BM, col0 = u.pn * BM + wc * 32 + 4 * fq;
        const bool lat = rt < ML; const int v = lat ? (rt >> 13) : 4;
        const float* xin = lat ? xl_in + (size_t)rt * D : xc_in + (size_t)(rt - ML) * D; float* xout = lat ? xl_out + (size_t)rt * D : xc_out + (size_t)(rt - ML) * D;
        f32x4 gv[2][2];
#pragma unroll
        for (int bj = 0; bj < 2; ++bj)
#pragma unroll
            for (int n = 0; n < 2; ++n) gv[bj][n] = *(const f32x4*)(gate + (size_t)v * NMOD + col0 + bj * HALF + n * 16);
#pragma unroll
        for (int ai = 0; ai < 2; ++ai)
#pragma unroll
            for (int m = 0; m < 4; ++m) { const size_t off = (size_t)(wr * 64 + fr + ai * HALF + m * 16) * D + col0;
#pragma unroll
                for (int bj = 0; bj < 2; ++bj)
#pragma unroll
                    for (int n = 0; n < 2; ++n) { const f32x4 xi = *(const f32x4*)(xin + off + bj * HALF + n * 16);
                        *(f32x4*)(xout + off + bj * HALF + n * 16) = xi + gv[bj][n] * acc[ai][bj][m][n]; } }
    }
};
struct EpiSwiglu {
    static constexpr bool PERM = true;
    bf16* O; int ldo;
    __device__ __forceinline__ bool zero_after(const Unit&) const { return true; }
    __device__ __forceinline__ void operator()(f32x4 (&acc)[2][2][4][2], const Unit& u, int wr, int wc, int fr, int fq) const {
        const int row0 = u.pm * BM + wr * 64 + fr, col0 = u.pn * HALF + wc * 32 + 8 * fq;
#pragma unroll
        for (int ai = 0; ai < 2; ++ai)
#pragma unroll
            for (int m = 0; m < 4; ++m) { bf16* rowp = O + (size_t)(row0 + ai * HALF + m * 16) * ldo + col0;
                float o[8];
#pragma unroll
                for (int n = 0; n < 2; ++n)
#pragma unroll
                    for (int j = 0; j < 4; ++j) { const float gt = acc[ai][0][m][n][j], up = acc[ai][1][m][n][j]; o[4 * n + j] = gt * sigmoidf_(gt) * up; }
                u32x4 w; w.x = pk2(o[0], o[1]); w.y = pk2(o[2], o[3]); w.z = pk2(o[4], o[5]); w.w = pk2(o[6], o[7]);
                *(u32x4*)rowp = w; }
    }
};
struct EpiBf16 {
    static constexpr bool PERM = true;
    bf16* O; int ldo;
    __device__ __forceinline__ bool zero_after(const Unit&) const { return true; }
    __device__ __forceinline__ void operator()(f32x4 (&acc)[2][2][4][2], const Unit& u, int wr, int wc, int fr, int fq) const {
        const int row0 = u.pm * BM + wr * 64 + fr, col0 = u.pn * BM + wc * 32 + 8 * fq;
#pragma unroll
        for (int ai = 0; ai < 2; ++ai)
#pragma unroll
            for (int m = 0; m < 4; ++m) { bf16* rowp = O + (size_t)(row0 + ai * HALF + m * 16) * ldo + col0;
#pragma unroll
                for (int bj = 0; bj < 2; ++bj) { const f32x4 v0 = acc[ai][bj][m][0], v1 = acc[ai][bj][m][1];
                    u32x4 w; w.x = pk2(v0[0], v0[1]); w.y = pk2(v0[2], v0[3]); w.z = pk2(v1[0], v1[1]); w.w = pk2(v1[2], v1[3]);
                    *(u32x4*)(rowp + bj * HALF) = w; } }
    }
};
}

typedef GAS unsigned gu32;
#define RLX_AGENT __ATOMIC_RELAXED, __HIP_MEMORY_SCOPE_AGENT
#define LDS_WAIT() asm volatile("s_waitcnt lgkmcnt(0)" ::: "memory")
#define VM_WAIT() asm volatile("s_waitcnt vmcnt(0)" ::: "memory")
#define MFMA16(a, b, c) __builtin_amdgcn_mfma_f32_16x16x32_bf16((a), (b), (c), 0, 0, 0)

#define XB_TMO      128
#define XB_XCNT(j)  (256  + 64 * (j))
#define XB_XSUB(j)  (1280 + 64 * (j))
#define XB_XGEN(j)  (2304 + 64 * (j))
#define XB_TOP      3328
#define XB_TOPGEN   3392
#define XCD_BAR_WORDS 3456
#define XB_SPIN_CAP (1u << 18)
__device__ __forceinline__ unsigned xb_ld(unsigned* p)              { return __hip_atomic_load(p, __ATOMIC_RELAXED, __HIP_MEMORY_SCOPE_AGENT); }
__device__ __forceinline__ unsigned xb_add(unsigned* p, unsigned v) { return __hip_atomic_fetch_add(p, v, __ATOMIC_RELAXED, __HIP_MEMORY_SCOPE_AGENT); }
__device__ __forceinline__ unsigned xb_xcc_id() { return (unsigned)__builtin_amdgcn_s_getreg((3 << 11) | 20) & 0xFu; }
#define XB_SPIN(cond, bar) do { unsigned _sp = 0; while (cond) { __builtin_amdgcn_s_sleep(1); \
    if ((++_sp & 255u) == 0u) { if (xb_ld(&(bar)[XB_TMO])) break; if (_sp > XB_SPIN_CAP) { atomicAdd(&(bar)[XB_TMO], 1u); break; } } } } while (0)
struct XcdBarrier { unsigned* bar; unsigned x; volatile LAS unsigned* st; };
__device__ __forceinline__ XcdBarrier xcd_barrier_post(unsigned* bar, volatile LAS unsigned* st) {
    XcdBarrier b; b.bar = bar; b.x = xb_xcc_id(); b.st = st;
    if (threadIdx.x == 0) (void)xb_add(&bar[XB_XCNT(b.x)], 1u);
    return b;
}
__device__ __forceinline__ void xcd_barrier_complete(unsigned* bar, unsigned x, unsigned& nloc, unsigned& nx) {
    const unsigned G = gridDim.x * gridDim.y * gridDim.z;
    unsigned sum, cnt, mine, sp = 0u;
    for (;;) {
        sum = 0u; cnt = 0u; mine = 0u;
#pragma unroll
        for (unsigned j = 0; j < 16; ++j) { const unsigned c = xb_ld(&bar[XB_XCNT(j)]); sum += c; cnt += (c > 0u) ? 1u : 0u; mine = (j == x) ? c : mine; }
        if (sum == G) break;
        __builtin_amdgcn_s_sleep(1);
        if ((++sp & 255u) == 0u) { if (xb_ld(&bar[XB_TMO])) break; if (sp > XB_SPIN_CAP) { atomicAdd(&bar[XB_TMO], 1u); break; } }
    }
    nloc = mine > 0u ? mine : 1u; nx = cnt > 0u ? cnt : 1u;
}
__device__ __forceinline__ void xcd_barrier(const XcdBarrier& b) {
    asm volatile("s_waitcnt vmcnt(0)" ::: "memory");
    __syncthreads();
    if (threadIdx.x == 0) {
        unsigned* bar = b.bar; unsigned bx_ = b.x;
        asm volatile("" : "+s"(bar), "+s"(bx_));
        __builtin_amdgcn_s_waitcnt(0);
        unsigned nloc = b.st[0], nx = b.st[1];
        if (nloc == 0u) { xcd_barrier_complete(bar, bx_, nloc, nx); b.st[0] = nloc; b.st[1] = nx; }
        const unsigned old = xb_add(&bar[XB_XSUB(bx_)], 1u);
        const unsigned gen = old / nloc;
        if (old + 1u == (gen + 1u) * nloc) {
            __builtin_amdgcn_fence(__ATOMIC_RELEASE, "agent");
            asm volatile("s_waitcnt vmcnt(0)" ::: "memory");
            const unsigned og = xb_add(&bar[XB_TOP], 1u);
            const unsigned tg = og / nx;
            if (og + 1u == (tg + 1u) * nx) xb_add(&bar[XB_TOPGEN], 1u);
            else XB_SPIN(xb_ld(&bar[XB_TOPGEN]) == tg, bar);
            __builtin_amdgcn_fence(__ATOMIC_ACQUIRE, "agent");
            xb_add(&bar[XB_XGEN(bx_)], 1u);
            asm volatile("s_waitcnt vmcnt(0)" ::: "memory");
        } else {
            XB_SPIN(xb_ld(&bar[XB_XGEN(bx_)]) == gen, bar);
            __builtin_amdgcn_fence(__ATOMIC_ACQUIRE, "agent");
            asm volatile("s_waitcnt vmcnt(0)" ::: "memory");
        }
    }
    __syncthreads();
}

__device__ __forceinline__ float wave_sum(float v) {
#pragma unroll
    for (int o = 1; o < 64; o <<= 1) v += __shfl_xor(v, o);
    return v;
}

__device__ __forceinline__ void transpose_item(const float* W, int N, bf16* WT, int ldk, int dst_row0, int dst_k0, int k0, int n0, LAS float* scr, int lane) {
#pragma unroll 8
    for (int i = 0; i < 32; ++i) { const int kk = 2 * i + (lane >> 5); scr[kk * 33 + (lane & 31)] = W[(size_t)(k0 + kk) * N + n0 + (lane & 31)]; }
    LDS_WAIT(); asm volatile("" ::: "memory");
    const int c = lane & 7;
#pragma unroll
    for (int j = 0; j < 4; ++j) { const int n = (lane >> 3) + 8 * j; const LAS float* s = scr + (8 * c) * 33 + n;
        u32x4 o; o.x = pk2(s[0 * 33], s[1 * 33]); o.y = pk2(s[2 * 33], s[3 * 33]); o.z = pk2(s[4 * 33], s[5 * 33]); o.w = pk2(s[6 * 33], s[7 * 33]);
        *(u32x4*)(WT + (size_t)(dst_row0 + n) * ldk + dst_k0 + k0 + 8 * c) = o; }
    LDS_WAIT(); asm volatile("" ::: "memory");
}
__device__ __forceinline__ void tr_matrix(const float* W, int K, int N, bf16* WT, int ldk, int dst_k0, int mode, int& base, int gw, int NGW, LAS float* scr, int lane) {
    const int nnb = N / 32, items = (K / 64) * nnb;
    const int first = (gw - base % NGW + NGW) % NGW;
    for (int it = first; it < items; it += NGW) { const int kb = it / nnb, nb = it - kb * nnb, n0 = 32 * nb;
        const int dr = mode == 0 ? n0 : (256 * (n0 >> 7) + (n0 & 127) + (mode == 2 ? 128 : 0));
        transpose_item(W, N, WT, ldk, dr, dst_k0, 64 * kb, n0, scr, lane); }
    base += items;
}

__device__ __forceinline__ void norm_row(const float* xrow, const float* g, const float* shift, const float* scale, bf16* orow, int lane, f32x4 (&hv)[4]) {
    f32x4 v[4]; float s = 0.f;
#pragma unroll
    for (int j = 0; j < 4; ++j) { v[j] = *(const f32x4*)(xrow + 4 * lane + 256 * j); s += (v[j].x * v[j].x + v[j].y * v[j].y) + (v[j].z * v[j].z + v[j].w * v[j].w); }
    const float rstd = 1.0f / sqrtf(wave_sum(s) * (1.f / D) + EPS);
#pragma unroll
    for (int j = 0; j < 4; ++j) { const int o = 4 * lane + 256 * j;
        const f32x4 gg = *(const f32x4*)(g + o), sh = *(const f32x4*)(shift + o), sc = *(const f32x4*)(scale + o);
        hv[j] = v[j] * rstd * gg * (sc + 1.0f) + sh;
        u32x2 w; w.x = pk2(hv[j].x, hv[j].y); w.y = pk2(hv[j].z, hv[j].w);
        *(u32x2*)(orow + o) = w; }
}

template <typename T> __device__ __forceinline__ T ldg_u(const void* ubase, unsigned voff) { return *(const T*)((const char*)ubase + voff); }
#define RFL(x) __builtin_amdgcn_readfirstlane(x)
struct AttnKV { bf16x8 k[4]; u32x4 v[4]; };
template <bool WINDOW>
__device__ __forceinline__ void attn_load(AttnKV& B, const char* kbase, const char* vbase, int st, unsigned klane, unsigned vlane) {
    constexpr int PS = WINDOW ? 64 : 32;
    const char* kp = kbase + (size_t)st * (PS * PW * 2); const char* vp = vbase + (size_t)st * (PS * 2);
    B.k[0] = ldg_u<bf16x8>(kp, klane); B.k[1] = ldg_u<bf16x8>(kp + 64, klane); B.k[2] = ldg_u<bf16x8>(kp + 16 * PW * 2, klane); B.k[3] = ldg_u<bf16x8>(kp + 16 * PW * 2 + 64, klane);
#pragma unroll
    for (int dt = 0; dt < 4; ++dt) { const u32x2 lo = ldg_u<u32x2>(vp + (size_t)(16 * dt) * VT_LD * 2, vlane), hi = ldg_u<u32x2>(vp + (size_t)(16 * dt) * VT_LD * 2 + 32, vlane);
        u32x4 w; w.x = lo.x; w.y = lo.y; w.z = hi.x; w.w = hi.y; B.v[dt] = w; }
}
template <bool WINDOW>
__device__ __forceinline__ void attn_step(const AttnKV& B, const bf16x8 (&qf)[2], LAS const float* rpbl, const float (&mk)[2][4], int st, float& mrun, float& lrun, f32x4 (&o)[4]) {
    f32x4 t0 = MFMA16(B.k[0], qf[0], ((f32x4){0.f, 0.f, 0.f, 0.f})); t0 = MFMA16(B.k[1], qf[1], t0);
    f32x4 t1 = MFMA16(B.k[2], qf[0], ((f32x4){0.f, 0.f, 0.f, 0.f})); t1 = MFMA16(B.k[3], qf[1], t1);
    if (WINDOW) {
#pragma unroll
        for (int j = 0; j < 4; ++j) { t0[j] = (t0[j] + rpbl[st * 64 + j]) + mk[0][j]; t1[j] = (t1[j] + rpbl[st * 64 + 16 + j]) + mk[1][j]; }
    }
    float cm = fmaxf(fmaxf(fmaxf(t0[0], t0[1]), fmaxf(t0[2], t0[3])), fmaxf(fmaxf(t1[0], t1[1]), fmaxf(t1[2], t1[3])));
    cm = fmaxf(cm, __shfl_xor(cm, 16)); cm = fmaxf(cm, __shfl_xor(cm, 32));
    const float mnew = fmaxf(mrun, cm), alpha = fast_exp2(mrun - mnew);
    float ls = 0.f;
#pragma unroll
    for (int j = 0; j < 4; ++j) { t0[j] = fast_exp2(t0[j] - mnew); t1[j] = fast_exp2(t1[j] - mnew); ls += t0[j] + t1[j]; }
    lrun = lrun * alpha + ls; mrun = mnew;
    u32x4 pw; pw.x = pk2(t0[0], t0[1]); pw.y = pk2(t0[2], t0[3]); pw.z = pk2(t1[0], t1[1]); pw.w = pk2(t1[2], t1[3]);
    const bf16x8 pf = __builtin_bit_cast(bf16x8, pw);
#pragma unroll
    for (int dt = 0; dt < 4; ++dt) { o[dt] = o[dt] * alpha; o[dt] = MFMA16(__builtin_bit_cast(bf16x8, B.v[dt]), pf, o[dt]); }
}
template <bool WINDOW>
__device__ __forceinline__ void attn_chunk(const char* kbase, const char* vbase, const bf16x8 (&qf)[2], LAS const float* rpbl, const float (&mk)[2][4], float& mrun, float& lrun, f32x4 (&o)[4], unsigned klane, unsigned vlane) {
    AttnKV A, B;
    attn_load<WINDOW>(A, kbase, vbase, 0, klane, vlane);
#pragma unroll 1
    for (int st = 0; st < 8; st += 2) {
        attn_load<WINDOW>(B, kbase, vbase, st + 1, klane, vlane);
        attn_step<WINDOW>(A, qf, rpbl, mk, st, mrun, lrun, o);
        attn_load<WINDOW>(A, kbase, vbase, min(st + 2, 7), klane, vlane);
        attn_step<WINDOW>(B, qf, rpbl, mk, st + 1, mrun, lrun, o);
    }
}
template <bool LATENT>
__device__ __forceinline__ void attn_unit(bf16* Z, const bf16* VT, LAS const float* rpb, int b_, int h_, int r_, int a_, int lane) {
    const int b = RFL(b_), h = RFL(h_), r = RFL(r_), a = RFL(a_);
    const int n = lane & 15, q = lane >> 4;
    const size_t tq0 = LATENT ? (size_t)(b * SEQ + r * 64 + a) : (size_t)(ML + b * CTXL + a);
    char* qbase = (char*)(Z + tq0 * PW + Q_OFF + h * 64);
    const unsigned klane = (unsigned)(n * PW + 8 * q) * 2u, vlane = (unsigned)(n * VT_LD + 4 * q) * 2u;
    bf16x8 qf[2]; qf[0] = ldg_u<bf16x8>(qbase, klane); qf[1] = ldg_u<bf16x8>(qbase + 64, klane);
    const char* zk = (const char*)(Z + K_OFF + h * 64); const char* vth = (const char*)(VT + (size_t)(b * 8 + h) * 64 * VT_LD);
    float mrun = -INFINITY, lrun = 0.f; f32x4 o[4];
#pragma unroll
    for (int dt = 0; dt < 4; ++dt) o[dt] = (f32x4){0.f, 0.f, 0.f, 0.f};
    float mk[2][4];
#pragma unroll
    for (int hf = 0; hf < 2; ++hf)
#pragma unroll
        for (int j = 0; j < 4; ++j) mk[hf][j] = 0.f;
    if (LATENT) { const int rbase = min(max(r - 4, 0), 120), s0 = min(max(a - 8, 0), 32), qc = a + n, cs = min(max(qc - 8, 0), 48);
#pragma unroll
        for (int hf = 0; hf < 2; ++hf)
#pragma unroll
            for (int j = 0; j < 4; ++j) { const int kc = s0 + 16 * hf + 4 * q + j; mk[hf][j] = ((kc >= cs) && (kc < cs + 16)) ? 0.f : -INFINITY; }
        LAS const float* rpbl = rpb + h * 960 + (rbase - r + 7) * 64 + (s0 + 4 * q - qc + 31);
        attn_chunk<true>(zk + (size_t)(b * SEQ + rbase * 64 + s0) * PW * 2, vth + (size_t)(rbase * 64 + s0) * 2, qf, rpbl, mk, mrun, lrun, o, klane, vlane); }
    attn_chunk<false>(zk + (size_t)(ML + b * CTXL) * PW * 2, vth + (size_t)SEQ * 2, qf, rpb, mk, mrun, lrun, o, klane, vlane);
    lrun += __shfl_xor(lrun, 16); lrun += __shfl_xor(lrun, 32);
    const float inv = 1.0f / lrun;
    const unsigned olane = (unsigned)(n * PW + 4 * q) * 2u;
#pragma unroll
    for (int dt = 0; dt < 4; ++dt) { u32x2 w; w.x = pk2(o[dt][0] * inv, o[dt][1] * inv); w.y = pk2(o[dt][2] * inv, o[dt][3] * inv);
        *(u32x2*)(qbase + 32 * dt + olane) = w; }
}

__device__ __forceinline__ void f1_unit(const bf16* Z, bf16* R, LAS const unsigned char* T64, LAS const unsigned char* TA, int b_, int g_, int l2_, int cb_, int lane) {
    const int b = RFL(b_), g = RFL(g_), l2 = RFL(l2_), cb = RFL(cb_);
    const int n = lane & 15, q = lane >> 4;
    const char* ubase = (const char*)(Z + (size_t)(b * SEQ + l2) * PW + g * 64); const unsigned ulane = (unsigned)(n * 64 * PW + 8 * q) * 2u;
    f32x4 pr[8], pi[8];
#pragma unroll
    for (int mt = 0; mt < 8; ++mt) { pr[mt] = (f32x4){0.f, 0.f, 0.f, 0.f}; pi[mt] = (f32x4){0.f, 0.f, 0.f, 0.f}; }
#pragma unroll
    for (int ks = 0; ks < 2; ++ks) {
        const bf16x8 bre = *(const LAS bf16x8*)(T64 + ((0 * 64 + 16 * cb + n) * 64 + 32 * ks + 8 * q) * 2);
        const bf16x8 bim = *(const LAS bf16x8*)(T64 + ((1 * 64 + 16 * cb + n) * 64 + 32 * ks + 8 * q) * 2);
#pragma unroll
        for (int mt = 0; mt < 8; ++mt) {
            const bf16x8 av = ldg_u<bf16x8>(ubase + ((size_t)(16 * mt * 64) * PW + 32 * ks) * 2, ulane);
            pr[mt] = MFMA16(av, bre, pr[mt]); pi[mt] = MFMA16(av, bim, pi[mt]); }
        __builtin_amdgcn_sched_barrier(0);
    }
    bf16x8 fr[4], fi[4], fn[4];
#pragma unroll
    for (int k2 = 0; k2 < 4; ++k2) {
        u32x4 wr_, wi_, wn_;
        wr_.x = pk2(pr[2 * k2][0], pr[2 * k2][1]); wr_.y = pk2(pr[2 * k2][2], pr[2 * k2][3]); wr_.z = pk2(pr[2 * k2 + 1][0], pr[2 * k2 + 1][1]); wr_.w = pk2(pr[2 * k2 + 1][2], pr[2 * k2 + 1][3]);
        wi_.x = pk2(pi[2 * k2][0], pi[2 * k2][1]); wi_.y = pk2(pi[2 * k2][2], pi[2 * k2][3]); wi_.z = pk2(pi[2 * k2 + 1][0], pi[2 * k2 + 1][1]); wi_.w = pk2(pi[2 * k2 + 1][2], pi[2 * k2 + 1][3]);
        wn_ = wr_ ^ 0x80008000u;
        fr[k2] = __builtin_bit_cast(bf16x8, wr_); fi[k2] = __builtin_bit_cast(bf16x8, wi_); fn[k2] = __builtin_bit_cast(bf16x8, wn_);
    }
    char* rbase = (char*)(R + (size_t)(b * 4 + g) * 128 * 64 * 128 + (size_t)l2 * 128 + 16 * cb); const unsigned rlane = (unsigned)(4 * q * 64 * 128 + n) * 2u;
#pragma unroll
    for (int mt = 0; mt < 8; ++mt) {
        f32x4 qr = (f32x4){0.f, 0.f, 0.f, 0.f}, qi = (f32x4){0.f, 0.f, 0.f, 0.f};
#pragma unroll
        for (int k2 = 0; k2 < 4; ++k2) {
            const bf16x8 ac = *(const LAS bf16x8*)(TA + (((0 * 8 + mt) * 4 + k2) * 64 + lane) * 16);
            const bf16x8 as = *(const LAS bf16x8*)(TA + (((1 * 8 + mt) * 4 + k2) * 64 + lane) * 16);
            qr = MFMA16(ac, fr[k2], qr); qr = MFMA16(as, fi[k2], qr); qi = MFMA16(ac, fi[k2], qi); qi = MFMA16(as, fn[k2], qi);
        }
#pragma unroll
        for (int j = 0; j < 4; ++j) { const int k1 = 16 * mt + 4 * q + j; const float ang = (float)((l2 * k1) & 8191) * (1.0f / 4096.0f);
            const float ct = cospif(ang), st = sinpif(ang);
            const float rr = qr[j] * ct + qi[j] * st, ri = qi[j] * ct - qr[j] * st;
            char* p = rbase + (size_t)((16 * mt + j) * 64 * 128) * 2;
            *(bf16*)(p + rlane) = (bf16)(pk2(rr, 0.f) & 0xffffu); *(bf16*)(p + 128 + rlane) = (bf16)(pk2(ri, 0.f) & 0xffffu); }
        __builtin_amdgcn_sched_barrier(0);
    }
}
__device__ __forceinline__ void f3_unit(const bf16* R, bf16* Z, LAS const unsigned char* T3F, LAS unsigned char* scr, int b, int g, int k1, int ch, int lane) {
    const int n = lane & 15, q = lane >> 4;
    const bf16* Rb = R + ((size_t)((b * 4 + g) * 128 + k1) * 64) * 128;
#pragma unroll
    for (int i = 0; i < 8; ++i) { const int p = lane + 64 * i, l2 = p >> 3, reim = (p >> 2) & 1, piece = p & 3;
        const u32x4 v = *(const u32x4*)(Rb + (l2 * 2 + reim) * 64 + 32 * ch + 8 * piece);
        *(LAS u32x4*)(scr + l2 * 144 + reim * 64 + piece * 16) = v; }
    LDS_WAIT(); asm volatile("" ::: "memory");
    bf16x8 bfr[2][4];
#pragma unroll
    for (int nt = 0; nt < 2; ++nt)
#pragma unroll
        for (int ks = 0; ks < 4; ++ks) { u32x4 w; unsigned e[8];
#pragma unroll
            for (int j = 0; j < 8; ++j) { const int l2 = 32 * (ks & 1) + 8 * q + j; e[j] = *(const LAS unsigned short*)(scr + l2 * 144 + (ks >> 1) * 64 + (16 * nt + n) * 2); }
            w.x = e[0] | (e[1] << 16); w.y = e[2] | (e[3] << 16); w.z = e[4] | (e[5] << 16); w.w = e[6] | (e[7] << 16);
            bfr[nt][ks] = __builtin_bit_cast(bf16x8, w); }
    const float sc = 0.00138106793f;
#pragma unroll
    for (int mt = 0; mt < 4; ++mt) {
        f32x4 y0 = (f32x4){0.f, 0.f, 0.f, 0.f}, y1 = (f32x4){0.f, 0.f, 0.f, 0.f};
#pragma unroll
        for (int ks = 0; ks < 4; ++ks) { const bf16x8 av = *(const LAS bf16x8*)(T3F + ((mt * 4 + ks) * 64 + lane) * 16);
            y0 = MFMA16(av, bfr[0][ks], y0); y1 = MFMA16(av, bfr[1][ks], y1); }
#pragma unroll
        for (int j = 0; j < 4; ++j) { const int k2 = 16 * mt + 4 * q + j; bf16* p = Z + (size_t)(b * SEQ + k1 + 128 * k2) * PW + g * 64 + 32 * ch + n;
            p[0] = (bf16)(pk2(y0[j] * sc, 0.f) & 0xffffu); p[16] = (bf16)(pk2(y1[j] * sc, 0.f) & 0xffffu); }
    }
    LDS_WAIT(); asm volatile("" ::: "memory");
}

struct Args { const float* in[23]; float* out; unsigned char* ws; };
__device__ __forceinline__ unsigned long long pt_get(LAS const unsigned long long* PT, int i) {
    const unsigned long long v = PT[i];
    const unsigned lo = __builtin_amdgcn_readfirstlane((unsigned)v), hi = __builtin_amdgcn_readfirstlane((unsigned)(v >> 32));
    return ((unsigned long long)hi << 32) | lo;
}
#define INP(i) ((const float*)(const GAS float*)pt_get(PT, (i)))
#define OUTP ((float*)(GAS float*)pt_get(PT, 23))
#define WSP(off) ((unsigned char*)(GAS unsigned char*)(pt_get(PT, 24) + (unsigned long long)(off)))

__global__ void __launch_bounds__(NWAVES * 64, 2) fwd_kernel(Args args) {
    extern __shared__ __attribute__((aligned(16))) unsigned char lds_raw[];
    LAS unsigned char* lds = (LAS unsigned char*)lds_raw;
    volatile LAS unsigned* MISC = (volatile LAS unsigned*)(lds + MISC_OFF);
    LAS unsigned long long* PT = (LAS unsigned long long*)(lds + LDSCTL_OFF + 512);
    const int tid = threadIdx.x, lane = tid & 63, wave = __builtin_amdgcn_readfirstlane(tid >> 6);
    const int G = gridDim.x; const int bx = blockIdx.x; const int vcu = (G % 8 == 0) ? (bx % 8) * (G / 8) + bx / 8 : bx;
    const int gw = vcu * NWAVES + wave, NGW = G * NWAVES;

    for (int u = tid; u < (LDS_BYTES - LDSCTL_OFF) / 4; u += NWAVES * 64) ((LAS unsigned*)(lds + LDSCTL_OFF))[u] = 0u;
    __syncthreads();
    if (tid < 23) PT[tid] = (unsigned long long)args.in[tid];
    if (tid == 23) PT[23] = (unsigned long long)args.out;
    if (tid == 24) PT[24] = (unsigned long long)args.ws;
    __syncthreads();
    XcdBarrier bar = xcd_barrier_post((unsigned*)WSP(WS_CTL) + CW_BAR, MISC + 8);
#define GRID_BAR() xcd_barrier(bar)

    {
            const int tid = fresh_tid(), lane = tid & 63; (void)tid; (void)lane;
        if (vcu < 192) {
            LAS float* S = (LAS float*)lds;
            LAS float* P = (LAS float*)(lds + 32768);
            { const float* c_in = INP(1); const float* cctx_in = INP(3);
              for (int i = tid; i < 5 * D; i += NWAVES * 64) { const int v = i >> 10, k = i & 1023; const float cv = v < 4 ? c_in[v * D + k] : cctx_in[k]; S[i] = cv / (1.0f + __expf(-cv)); } }
            __syncthreads();
            const int l = vcu / 96, j = (vcu % 96) * 64 + lane;
            const float* W = INP(6) + (size_t)l * D * NMOD + j;
            float a0 = 0.f, a1 = 0.f, a2 = 0.f, a3 = 0.f, a4 = 0.f;
#pragma unroll 8
            for (int kk = 0; kk < 128; ++kk) { const int k = wave * 128 + kk; const float w = W[(size_t)k * NMOD];
                a0 += S[k] * w; a1 += S[D + k] * w; a2 += S[2 * D + k] * w; a3 += S[3 * D + k] * w; a4 += S[4 * D + k] * w; }
            P[(wave * 5 + 0) * 64 + lane] = a0; P[(wave * 5 + 1) * 64 + lane] = a1; P[(wave * 5 + 2) * 64 + lane] = a2; P[(wave * 5 + 3) * 64 + lane] = a3; P[(wave * 5 + 4) * 64 + lane] = a4;
            __syncthreads();
            if (wave < 5) { float s = INP(7)[l * NMOD + j];
#pragma unroll
                for (int w8 = 0; w8 < 8; ++w8) s += P[(w8 * 5 + wave) * 64 + lane];
                ((float*)WSP(WS_MOD))[((size_t)l * 5 + wave) * NMOD + j] = s; }
        }
        __syncthreads();
        LAS float* scr = (LAS float*)(lds + wave * 16384);
        int base = 0;
#pragma unroll 1
        for (int l = 0; l < 2; ++l) {
            tr_matrix(INP(8) + (size_t)l * D * PW, D, PW, (bf16*)WSP(WS_WIN) + (size_t)l * PW * D, D, 0, 0, base, gw, NGW, scr, lane);
            tr_matrix(INP(11) + (size_t)l * 256 * D, 256, D, (bf16*)WSP(WS_WCAT) + (size_t)l * D * D, D, 0, 0, base, gw, NGW, scr, lane);
            tr_matrix(INP(12) + (size_t)l * 512 * D, 512, D, (bf16*)WSP(WS_WCAT) + (size_t)l * D * D, D, 256, 0, base, gw, NGW, scr, lane);
            tr_matrix(INP(13) + (size_t)l * 256 * D, 256, D, (bf16*)WSP(WS_WCAT) + (size_t)l * D * D, D, 768, 0, base, gw, NGW, scr, lane);
            tr_matrix(INP(14) + (size_t)l * D * D, D, D, (bf16*)WSP(WS_WOUT) + (size_t)l * D * D, D, 0, 0, base, gw, NGW, scr, lane);
        }
        tr_matrix(INP(15), D, DFF, (bf16*)WSP(WS_WGU0), D, 0, 1, base, gw, NGW, scr, lane);
        tr_matrix(INP(16), D, DFF, (bf16*)WSP(WS_WGU0), D, 0, 2, base, gw, NGW, scr, lane);
        tr_matrix(INP(17), DFF, D, (bf16*)WSP(WS_WD0), DFF, 0, 0, base, gw, NGW, scr, lane);
    }
    GRID_BAR();

#pragma unroll 1
    for (int l = 0; l < 2; ++l) {
        const int Mmix = (l == 0) ? MT : ML;

        {
            const int tid = fresh_tid(), lane = tid & 63; (void)tid; (void)lane;
            const float* modl = (const float*)WSP(WS_MOD) + (size_t)l * 5 * NMOD; bf16* HX = (bf16*)WSP(WS_HX); const float* g1 = INP(4) + l * D;
            const float* xl_cur = (l == 0) ? INP(0) : (const float*)OUTP; const float* xc_cur = (l == 0) ? INP(2) : (const float*)WSP(WS_XC);
            for (int row = gw; row < MT; row += NGW) {
                const bool lat = row < ML; const int v = lat ? (row >> 13) : 4;
                const float* xr = lat ? xl_cur + (size_t)row * D : xc_cur + (size_t)(row - ML) * D;
                f32x4 hv[4]; norm_row(xr, g1, modl + (size_t)v * NMOD, modl + (size_t)v * NMOD + D, HX + (size_t)row * D, lane, hv);
            }
        }
        GRID_BAR();

        { pg8::Gemm g{D, D}; pg8::SchedPlain S; S.init(MT, PW, D, (const bf16*)WSP(WS_HX), D, (const bf16*)WSP(WS_WIN) + (size_t)l * PW * D, D, fresh_s(G), fresh_s(bx));
          pg8::EpiInProj E{(bf16*)WSP(WS_Z), (bf16*)WSP(WS_VT)};
          pg8::gemm_phase<pg8::EpiInProj, pg8::SchedPlain>(lds, g, S, E); }
        GRID_BAR();

        {
            const int tid = fresh_tid(), lane = tid & 63; (void)tid; (void)lane;
            LAS unsigned char* T64 = lds;
            LAS unsigned char* TA = lds + 16384;
            LAS float* RPB = (LAS float*)(lds + 81920);
            LAS float* C64 = (LAS float*)(lds + 114688);
            LAS float* CW = (LAS float*)(lds + 114688 + 512);
            for (int i = tid; i < 2 * 64 * 64; i += NWAVES * 64) { const int reim = i >> 12, cp = (i >> 6) & 63, c = i & 63; const float ang = (float)((c * cp) & 63) * (1.0f / 32.0f);
                const float v = reim ? -sinpif(ang) : cospif(ang); ((LAS bf16*)T64)[i] = (bf16)(pk2(v, 0.f) & 0xffffu); }
            for (int i = tid; i < 2 * 8 * 4 * 64 * 8; i += NWAVES * 64) { const int e = i & 7, ln = (i >> 3) & 63, k2 = (i >> 9) & 3, mt = (i >> 11) & 7, cs = i >> 14;
                const int k1 = 16 * mt + (ln & 15), qq = ln >> 4, l1 = 32 * k2 + (e < 4 ? 4 * qq + e : 16 + 4 * qq + (e - 4));
                const float ang = (float)((k1 * l1) & 127) * (1.0f / 64.0f); const float v = cs ? sinpif(ang) : cospif(ang);
                ((LAS bf16*)TA)[i] = (bf16)(pk2(v, 0.f) & 0xffffu); }
            { const float* rp = INP(10) + (size_t)l * 8 * 465; for (int i = tid; i < 8 * 15 * 64; i += NWAVES * 64) { const int dc = (i & 63) - 16; RPB[i] = (dc >= 0 && dc <= 30) ? rp[(i >> 6) * 31 + dc] * 1.44269504088896f : 0.f; } }
            if (tid < 64) { const float ang = (float)tid * (1.0f / 32.0f); C64[tid] = cospif(ang); C64[64 + tid] = sinpif(ang); }
            { const float* cw = INP(9) + l * 768; for (int i = tid; i < 768; i += NWAVES * 64) CW[i] = cw[i]; }
            __syncthreads();
            bf16* Z = (bf16*)WSP(WS_Z);
#ifndef SKIP_F1
            { bf16* RB = (bf16*)WSP(WS_R);
              _Pragma("unroll 1") for (int uid = gw; uid < 4096; uid += NGW) f1_unit(Z, RB, T64, TA, uid >> 10, (uid >> 8) & 3, (uid >> 2) & 63, uid & 3, lane); }
#endif
            if (l == 0) { float* CP = (float*)WSP(WS_CP);
              for (int it = vcu * 512 + tid; it < MC * 256; it += G * 512) { const int cp = it & 63, gg = (it >> 6) & 3, tok = it >> 8;
                const bf16* up = Z + (size_t)(ML + tok) * PW + gg * 64; float pr = 0.f, pi = 0.f;
#pragma unroll
                for (int c8 = 0; c8 < 8; ++c8) { const u32x4 w = *(const u32x4*)(up + 8 * c8); const float uv[8] = {bflo(w.x), bfhi(w.x), bflo(w.y), bfhi(w.y), bflo(w.z), bfhi(w.z), bflo(w.w), bfhi(w.w)};
#pragma unroll
                    for (int j = 0; j < 8; ++j) { const int idx = ((8 * c8 + j) * cp) & 63; pr += uv[j] * C64[idx]; pi -= uv[j] * C64[64 + idx]; } }
                CP[((size_t)(tok * 4 + gg) * 2) * 64 + cp] = pr; CP[((size_t)(tok * 4 + gg) * 2 + 1) * 64 + cp] = pi; } }
            for (int it = vcu * 512 + tid; it < Mmix * 32; it += G * 512) { const int row = it >> 5, ch = (it & 31) * 8;
                const bool lat = row < ML; const int pos = lat ? (row & 8191) : ((row - ML) & 255), len = lat ? SEQ : CTXL;
                bf16* zr = Z + (size_t)row * PW; float p[3][8];
#pragma unroll
                for (int d = 0; d < 3; ++d) { const bool ok = (d == 1) || (d == 0 ? pos > 0 : pos < len - 1);
                    if (ok) { const bf16* rr = zr + (ptrdiff_t)(d - 1) * PW; const u32x4 wu = *(const u32x4*)(rr + U_OFF + ch), wc = *(const u32x4*)(rr + C_OFF + ch);
                        p[d][0] = bflo(wu.x) * bflo(wc.x); p[d][1] = bfhi(wu.x) * bfhi(wc.x); p[d][2] = bflo(wu.y) * bflo(wc.y); p[d][3] = bfhi(wu.y) * bfhi(wc.y);
                        p[d][4] = bflo(wu.z) * bflo(wc.z); p[d][5] = bfhi(wu.z) * bfhi(wc.z); p[d][6] = bflo(wu.w) * bflo(wc.w); p[d][7] = bfhi(wu.w) * bfhi(wc.w); }
                    else {
#pragma unroll
                        for (int j = 0; j < 8; ++j) p[d][j] = 0.f; } }
                const u32x4 wb = *(const u32x4*)(zr + B_OFF + ch); const float zb[8] = {bflo(wb.x), bfhi(wb.x), bflo(wb.y), bfhi(wb.y), bflo(wb.z), bfhi(wb.z), bflo(wb.w), bfhi(wb.w)};
                float o[8];
#pragma unroll
                for (int j = 0; j < 8; ++j) o[j] = zb[j] * (CW[ch + j] * p[0][j] + CW[256 + ch + j] * p[1][j] + CW[512 + ch + j] * p[2][j]);
                u32x4 w; w.x = pk2(o[0], o[1]); w.y = pk2(o[2], o[3]); w.z = pk2(o[4], o[5]); w.w = pk2(o[6], o[7]);
                *(u32x4*)(zr + B_OFF + ch) = w; }
#ifndef SKIP_ATTN
            { const bf16* VT = (const bf16*)WSP(WS_VT);
              _Pragma("unroll 1") for (int uid = gw; uid < 16384; uid += NGW) attn_unit<true>(Z, VT, RPB, uid >> 12, (uid >> 9) & 7, (uid >> 2) & 127, (uid & 3) * 16, lane);
              if (l == 0) _Pragma("unroll 1") for (int uid = gw; uid < 512; uid += NGW) attn_unit<false>(Z, VT, RPB, uid >> 7, (uid >> 4) & 7, 0, (uid & 15) * 16, lane); }
#endif
        }
        GRID_BAR();

        {
            const int tid = fresh_tid(), lane = tid & 63; (void)tid; (void)lane;
            LAS unsigned char* T3F = lds;
            LAS float* C256 = (LAS float*)(lds + 16384);
            LAS unsigned char* scr = lds + 32768 + wave * 9216;
            for (int i = tid; i < 4 * 4 * 64 * 8; i += NWAVES * 64) { const int e = i & 7, ln = (i >> 3) & 63, ks = (i >> 9) & 3, mt = i >> 11;
                const int k2 = 16 * mt + (ln & 15), kap = 32 * ks + 8 * (ln >> 4) + e, l2 = kap & 63;
                const float ang = (float)((k2 * l2) & 63) * (1.0f / 32.0f); const float v = (kap >= 64) ? sinpif(ang) : cospif(ang);
                ((LAS bf16*)T3F)[i] = (bf16)(pk2(v, 0.f) & 0xffffu); }
            if (tid < 256) { const float ang = (float)tid * (1.0f / 128.0f); C256[tid] = cospif(ang); C256[256 + tid] = sinpif(ang); }
            __syncthreads();
            bf16* Z = (bf16*)WSP(WS_Z);
#ifndef SKIP_F3
            { const bf16* RB = (const bf16*)WSP(WS_R);
              _Pragma("unroll 1") for (int uid = gw; uid < 4096; uid += NGW) f3_unit(RB, Z, T3F, scr, uid >> 10, (uid >> 8) & 3, (uid >> 1) & 127, uid & 1, lane); }
#endif
            if (l == 0) { const float* CP = (const float*)WSP(WS_CP);
              for (int it = vcu * 512 + tid; it < MC * 256; it += G * 512) { const int cp = it & 63, gg = (it >> 6) & 3, lp = (it >> 8) & 255, b = it >> 16;
                const float* pp = CP + ((size_t)(b * CTXL) * 4 + gg) * 128 + cp; float y = 0.f;
#pragma unroll 4
                for (int li = 0; li < CTXL; ++li) { const int idx = (li * lp) & 255; y += C256[idx] * pp[(size_t)li * 512] + C256[256 + idx] * pp[(size_t)li * 512 + 64]; }
                Z[(size_t)(ML + b * CTXL + lp) * PW + gg * 64 + cp] = (bf16)(pk2(y * (1.0f / 128.0f), 0.f) & 0xffffu); } }
        }
        GRID_BAR();

        { pg8::Gemm g{PW, D}; pg8::SchedMerge S{Mmix / 256, fresh_s(G), fresh_s(bx), (const char*)WSP(WS_Z), (const char*)((const bf16*)WSP(WS_WCAT) + (size_t)l * D * D)};
          pg8::EpiMerge E{(const bf16*)WSP(WS_Z), (bf16*)WSP(WS_HX)};
          pg8::gemm_phase<pg8::EpiMerge, pg8::SchedMerge>(lds, g, S, E); }
        GRID_BAR();

        { pg8::Gemm g{D, D}; pg8::SchedPlain S; S.init(Mmix, D, D, (const bf16*)WSP(WS_HX), D, (const bf16*)WSP(WS_WOUT) + (size_t)l * D * D, D, fresh_s(G), fresh_s(bx));
          pg8::EpiResid E{(l == 0) ? INP(0) : (const float*)OUTP, (l == 0) ? INP(2) : (const float*)WSP(WS_XC), OUTP, (float*)WSP(WS_XC), (const float*)WSP(WS_MOD) + (size_t)l * 5 * NMOD + 2 * D};
          pg8::gemm_phase<pg8::EpiResid, pg8::SchedPlain>(lds, g, S, E); }
        GRID_BAR();

        if (l == 0) {
            {
            const int tid = fresh_tid(), lane = tid & 63; (void)tid; (void)lane;
                const float* modl = (const float*)WSP(WS_MOD); bf16* HX = (bf16*)WSP(WS_HX); const float* g2 = INP(5); const float* xl = OUTP; const float* xc = (const float*)WSP(WS_XC);
                for (int row = gw; row < MT; row += NGW) {
                    const bool lat = row < ML; const int v = lat ? (row >> 13) : 4;
                    const float* xr = lat ? xl + (size_t)row * D : xc + (size_t)(row - ML) * D;
                    f32x4 hv[4]; norm_row(xr, g2, modl + (size_t)v * NMOD + 3 * D, modl + (size_t)v * NMOD + 4 * D, HX + (size_t)row * D, lane, hv);
                }
            }
            GRID_BAR();
            { pg8::Gemm g{D, D}; pg8::SchedPlain S; S.init(MT, 2 * DFF, D, (const bf16*)WSP(WS_HX), D, (const bf16*)WSP(WS_WGU0), D, fresh_s(G), fresh_s(bx));
              pg8::EpiSwiglu E{(bf16*)WSP(WS_G), DFF};
              pg8::gemm_phase<pg8::EpiSwiglu, pg8::SchedPlain>(lds, g, S, E); }
            GRID_BAR();
            { pg8::Gemm g{DFF, DFF}; pg8::SchedPlain S; S.init(MT, D, DFF, (const bf16*)WSP(WS_G), DFF, (const bf16*)WSP(WS_WD0), DFF, fresh_s(G), fresh_s(bx));
              pg8::EpiResid E{OUTP, (const float*)WSP(WS_XC), OUTP, (float*)WSP(WS_XC), (const float*)WSP(WS_MOD) + 5 * D};
              pg8::gemm_phase<pg8::EpiResid, pg8::SchedPlain>(lds, g, S, E); }
            GRID_BAR();
        } else {
            {
            const int tid = fresh_tid(), lane = tid & 63; (void)tid; (void)lane;
                LAS float* WR = (LAS float*)lds;
                LAS int* LC = (LAS int*)(lds + 32768);
                LAS unsigned* RT = (LAS unsigned*)(lds + 32768 + 64);
                { const float* wr = INP(18); for (int i = tid; i < D * NE; i += NWAVES * 64) WR[i] = wr[i]; }
                if (tid < 16) LC[tid] = 0;
                __syncthreads();
                const int rpw = ML / (G * NWAVES);
                {
                const float* modl = (const float*)WSP(WS_MOD) + (size_t)5 * NMOD; bf16* HX = (bf16*)WSP(WS_HX); const float* g2 = INP(5) + D; const float* xl = OUTP;
#pragma unroll 1
                for (int i = 0; i < rpw; ++i) { const int rl = wave * rpw + i, row = vcu * (rpw * NWAVES) + rl, v = row >> 13;
                    f32x4 hv[4]; norm_row(xl + (size_t)row * D, g2, modl + (size_t)v * NMOD + 3 * D, modl + (size_t)v * NMOD + 4 * D, HX + (size_t)row * D, lane, hv);
                    float lg[NE];
#pragma unroll
                    for (int e = 0; e < NE; ++e) lg[e] = 0.f;
#pragma unroll
                    for (int j = 0; j < 4; ++j)
#pragma unroll
                        for (int cc = 0; cc < 4; ++cc) { const int k = 4 * lane + 256 * j + cc; const f32x4 w0 = *(const LAS f32x4*)(WR + k * 8), w1 = *(const LAS f32x4*)(WR + k * 8 + 4); const float hvv = hv[j][cc];
                            lg[0] += hvv * w0.x; lg[1] += hvv * w0.y; lg[2] += hvv * w0.z; lg[3] += hvv * w0.w; lg[4] += hvv * w1.x; lg[5] += hvv * w1.y; lg[6] += hvv * w1.z; lg[7] += hvv * w1.w; }
#pragma unroll
                    for (int e = 0; e < NE; ++e) lg[e] = wave_sum(lg[e]);
                    int e0 = 0; float v0 = lg[0];
#pragma unroll
                    for (int e = 1; e < NE; ++e) if (lg[e] > v0) { v0 = lg[e]; e0 = e; }
                    int e1 = -1; float v1 = -INFINITY;
#pragma unroll
                    for (int e = 0; e < NE; ++e) if (e != e0 && lg[e] > v1) { v1 = lg[e]; e1 = e; }
                    const float w1 = 1.0f / (1.0f + __expf(v0 - v1)), w0 = 1.0f - w1;
                    if (lane == 0) { const int s0 = __hip_atomic_fetch_add(LC + e0, 1, __ATOMIC_RELAXED, __HIP_MEMORY_SCOPE_WORKGROUP), s1 = __hip_atomic_fetch_add(LC + e1, 1, __ATOMIC_RELAXED, __HIP_MEMORY_SCOPE_WORKGROUP);
                        RT[rl * 6 + 0] = (unsigned)e0; RT[rl * 6 + 1] = (unsigned)s0; RT[rl * 6 + 2] = (unsigned)e1; RT[rl * 6 + 3] = (unsigned)s1; RT[rl * 6 + 4] = __float_as_uint(w0); RT[rl * 6 + 5] = __float_as_uint(w1); }
                }
                }
                __syncthreads();
                if (tid < NE) LC[8 + tid] = (int)xb_add((unsigned*)WSP(WS_CTL) + CW_CNT + 64 * tid, (unsigned)LC[tid]);
                __syncthreads();
                if (tid < rpw * NWAVES) { const int row = vcu * (rpw * NWAVES) + tid; const unsigned e0 = RT[tid * 6], e1 = RT[tid * 6 + 2];
                    u32x4 r; r.x = e0 | ((unsigned)(LC[8 + e0] + (int)RT[tid * 6 + 1]) << 8); r.y = e1 | ((unsigned)(LC[8 + e1] + (int)RT[tid * 6 + 3]) << 8); r.z = RT[tid * 6 + 4]; r.w = RT[tid * 6 + 5];
                    ((u32x4*)WSP(WS_ROUTE))[row] = r; }
                __syncthreads();
                LAS float* scr = (LAS float*)(lds + wave * 16384);
                int base = 0;
#pragma unroll 1
                for (int e = 0; e < NE; ++e) {
                    tr_matrix(INP(19) + (size_t)e * D * DFE, D, DFE, (bf16*)WSP(WS_WMGU) + (size_t)e * 2 * DFE * D, D, 0, 1, base, gw, NGW, scr, lane);
                    tr_matrix(INP(20) + (size_t)e * D * DFE, D, DFE, (bf16*)WSP(WS_WMGU) + (size_t)e * 2 * DFE * D, D, 0, 2, base, gw, NGW, scr, lane);
                    tr_matrix(INP(21) + (size_t)e * DFE * D, DFE, D, (bf16*)WSP(WS_WMD) + (size_t)e * D * DFE, DFE, 0, 0, base, gw, NGW, scr, lane);
                }
            }
            GRID_BAR();
            LAS int* TP = (LAS int*)(lds + LDSCTL_OFF + 1024);
            if (tid == 0) { int acc_t = 0; unsigned* cnt = (unsigned*)WSP(WS_CTL) + CW_CNT;
                for (int e = 0; e < NE; ++e) { TP[e] = acc_t; acc_t += ((int)xb_ld(cnt + 64 * e) + 255) >> 8; }
                TP[NE] = acc_t; }
            __syncthreads();
            {
                const int tid = fresh_tid(), lane = tid & 63; (void)tid;
                u32x4* ROUTE = (u32x4*)WSP(WS_ROUTE); const bf16* HX = (const bf16*)WSP(WS_HX); bf16* XY = (bf16*)WSP(WS_XY);
                for (int row = gw; row < ML; row += NGW) { const u32x4 r = ROUTE[row];
                    const unsigned p0 = (unsigned)(TP[r.x & 255u] * 256) + (r.x >> 8), p1 = (unsigned)(TP[r.y & 255u] * 256) + (r.y >> 8);
                    const u32x4 h0 = *(const u32x4*)(HX + (size_t)row * D + 8 * lane), h1 = *(const u32x4*)(HX + (size_t)row * D + 512 + 8 * lane);
                    *(u32x4*)(XY + (size_t)p0 * D + 8 * lane) = h0; *(u32x4*)(XY + (size_t)p0 * D + 512 + 8 * lane) = h1;
                    *(u32x4*)(XY + (size_t)p1 * D + 8 * lane) = h0; *(u32x4*)(XY + (size_t)p1 * D + 512 + 8 * lane) = h1;
                    if (lane == 0) { u32x4 r2; r2.x = p0; r2.y = p1; r2.z = r.z; r2.w = r.w; ROUTE[row] = r2; } }
            }
            GRID_BAR();
            const int ntiles = __builtin_amdgcn_readfirstlane(TP[NE]);
#pragma unroll 1
            for (int t0 = 0; t0 < ntiles; t0 += MOE_CHUNK) { const int ntc = min(MOE_CHUNK, ntiles - t0);
                { pg8::Gemm g{D, D}; pg8::SchedMoeUp S;
#pragma unroll
                  for (int e = 0; e <= NE; ++e) S.T.pre[e] = __builtin_amdgcn_readfirstlane(TP[e]);
                  S.t0 = t0; S.ntc = ntc; S.G = fresh_s(G); S.c = fresh_s(bx); S.X = (const char*)WSP(WS_XY); S.W = (const char*)WSP(WS_WMGU);
                  pg8::EpiSwiglu E{(bf16*)WSP(WS_H), DFE};
                  pg8::gemm_phase<pg8::EpiSwiglu, pg8::SchedMoeUp>(lds, g, S, E); }
                GRID_BAR();
                { pg8::Gemm g{DFE, DFE}; pg8::SchedMoeDown S;
#pragma unroll
                  for (int e = 0; e <= NE; ++e) S.T.pre[e] = __builtin_amdgcn_readfirstlane(TP[e]);
                  S.t0 = t0; S.ntc = ntc; S.G = fresh_s(G); S.c = fresh_s(bx); S.H = (const char*)WSP(WS_H); S.W = (const char*)WSP(WS_WMD);
                  pg8::EpiBf16 E{(bf16*)WSP(WS_XY), D};
                  pg8::gemm_phase<pg8::EpiBf16, pg8::SchedMoeDown>(lds, g, S, E); }
                GRID_BAR();
            }
            {
            const int tid = fresh_tid(), lane = tid & 63; (void)tid; (void)lane;
                const u32x4* ROUTE = (const u32x4*)WSP(WS_ROUTE); const bf16* XY = (const bf16*)WSP(WS_XY); const float* modl = (const float*)WSP(WS_MOD) + (size_t)5 * NMOD; float* OUT = OUTP; const float* fg = INP(22);
                for (int row = gw; row < ML; row += NGW) { const u32x4 r = ROUTE[row]; const float w0 = __uint_as_float(r.z), w1 = __uint_as_float(r.w); const int v = row >> 13;
                    const float* g2 = modl + (size_t)v * NMOD + 5 * D; float* xr = OUT + (size_t)row * D; float val[16]; float ss = 0.f;
#pragma unroll
                    for (int jj = 0; jj < 2; ++jj) { const int o = 8 * lane + 512 * jj;
                        const u32x4 y0 = *(const u32x4*)(XY + (size_t)r.x * D + o), y1 = *(const u32x4*)(XY + (size_t)r.y * D + o);
                        const f32x4 xa = *(const f32x4*)(xr + o), xb = *(const f32x4*)(xr + o + 4), ga = *(const f32x4*)(g2 + o), gb = *(const f32x4*)(g2 + o + 4);
                        const float a0[8] = {bflo(y0.x), bfhi(y0.x), bflo(y0.y), bfhi(y0.y), bflo(y0.z), bfhi(y0.z), bflo(y0.w), bfhi(y0.w)};
                        const float a1[8] = {bflo(y1.x), bfhi(y1.x), bflo(y1.y), bfhi(y1.y), bflo(y1.z), bfhi(y1.z), bflo(y1.w), bfhi(y1.w)};
                        const float xv[8] = {xa.x, xa.y, xa.z, xa.w, xb.x, xb.y, xb.z, xb.w}, gv[8] = {ga.x, ga.y, ga.z, ga.w, gb.x, gb.y, gb.z, gb.w};
#pragma unroll
                        for (int j = 0; j < 8; ++j) { const float t = xv[j] + gv[j] * (w0 * a0[j] + w1 * a1[j]); val[8 * jj + j] = t; ss += t * t; } }
                    const float rstd = 1.0f / sqrtf(wave_sum(ss) * (1.f / D) + EPS);
#pragma unroll
                    for (int jj = 0; jj < 2; ++jj) { const int o = 8 * lane + 512 * jj; const f32x4 fa = *(const f32x4*)(fg + o), fb = *(const f32x4*)(fg + o + 4);
                        *(f32x4*)(xr + o) = (f32x4){val[8 * jj] * rstd * fa.x, val[8 * jj + 1] * rstd * fa.y, val[8 * jj + 2] * rstd * fa.z, val[8 * jj + 3] * rstd * fa.w};
                        *(f32x4*)(xr + o + 4) = (f32x4){val[8 * jj + 4] * rstd * fb.x, val[8 * jj + 5] * rstd * fb.y, val[8 * jj + 6] * rstd * fb.z, val[8 * jj + 7] * rstd * fb.w}; }
                }
            }
        }
    }
}

extern "C" void kernel_launch(void* const* d_in, const int* in_sizes, int n_in, void* d_out, int out_size, void* d_ws, size_t ws_size, hipStream_t stream) {
    static int grid = 0;
    if (grid == 0) {
        if (n_in != 23 || out_size != ML * D || ws_size < WS_END) { fprintf(stderr, "kernel_launch: unexpected problem (n_in %d, out %d, ws %zu)\n", n_in, out_size, ws_size); grid = -1; return; }
        int dev = 0, cus = 0, per_cu = 0;
        if (hipGetDevice(&dev) != hipSuccess || hipDeviceGetAttribute(&cus, hipDeviceAttributeMultiprocessorCount, dev) != hipSuccess) { grid = -1; return; }
        if (hipFuncSetAttribute((const void*)fwd_kernel, hipFuncAttributeMaxDynamicSharedMemorySize, LDS_BYTES) != hipSuccess) { fprintf(stderr, "kernel_launch: hipFuncSetAttribute failed\n"); grid = -1; return; }
        if (hipOccupancyMaxActiveBlocksPerMultiprocessor(&per_cu, (const void*)fwd_kernel, NWAVES * 64, LDS_BYTES) != hipSuccess || per_cu < 1) { fprintf(stderr, "kernel_launch: occupancy query says %d\n", per_cu); }
        (void)hipGetLastError();
        grid = cus;
        if (grid != 256) { fprintf(stderr, "kernel_launch: built for 256 CUs, device has %d\n", cus); grid = -1; return; }
    }
    if (grid < 0) return;
    if (hipMemsetAsync((char*)d_ws + WS_CTL, 0, CTL_ZERO_BYTES, stream) != hipSuccess) return;
    Args a{};
    for (int i = 0; i < 23; ++i) a.in[i] = (const float*)d_in[i];
    a.out = (float*)d_out; a.ws = (unsigned char*)d_ws;
    hipLaunchKernelGGL(fwd_kernel, dim3(grid), dim3(NWAVES * 64), LDS_BYTES, stream, a);
}
```

```cpp
#include <hip/hip_runtime.h>
#include <cstdio>
#include <cstdint>

#define LAS __attribute__((address_space(3)))
#define GAS __attribute__((address_space(1)))
typedef unsigned short bf16;
typedef short bf16x8 __attribute__((ext_vector_type(8)));
typedef float f32x4 __attribute__((ext_vector_type(4)));
typedef float f32x2 __attribute__((ext_vector_type(2)));
typedef unsigned u32x4 __attribute__((ext_vector_type(4)));
typedef unsigned u32x2 __attribute__((ext_vector_type(2)));
typedef __bf16 bf16x2_t __attribute__((ext_vector_type(2)));

constexpr int D = 1024, BATCH = 4, SEQ = 8192, CTXL = 256;
constexpr int ML = BATCH * SEQ, MC = BATCH * CTXL, MT = ML + MC;
constexpr int ZP = 2688;
constexpr int PW = 5632, Q_OFF = 256, K_OFF = 768, V_OFF = 1280, U_OFF = 1792, B_OFF = 2048, C_OFF = 2304, G_OFF = 2560;
constexpr int DFF = 2816, DFE = 3584, NE = 8;
constexpr int VT_LD = SEQ + CTXL + 128;
constexpr int NMOD = 6 * D;
constexpr float EPS = 1e-6f;
constexpr int MOE_CHUNK = 64;

constexpr size_t MiB = 1u << 20;
constexpr size_t WS_CTL = 0, CTL_ZERO_BYTES = 1 * MiB;
constexpr size_t WS_MOD = 1 * MiB;
constexpr size_t WS_ROUTE = 1 * MiB + 256 * 1024;
constexpr size_t WS_TAB = 1 * MiB + 768 * 1024;
constexpr size_t WS_CP = 2 * MiB;
constexpr size_t WS_XC = 4 * MiB;
constexpr size_t WS_WIN = 8 * MiB;
constexpr size_t WS_WCAT = 30 * MiB;
constexpr size_t WS_WOUT = 34 * MiB;
constexpr size_t WS_WGU0 = 38 * MiB;
constexpr size_t WS_WD0 = 49 * MiB;
constexpr size_t WS_HX = 55 * MiB;
constexpr size_t WS_Z = 121 * MiB;
constexpr size_t WS_GQ = 295 * MiB;
constexpr size_t WS_VT = 394 * MiB;
constexpr size_t WS_R = 428 * MiB;
constexpr size_t WS_PART = 533 * MiB;
constexpr size_t WS_END = 577 * MiB;
constexpr size_t WS_G = WS_Z;
constexpr size_t WS_WMGU = 121 * MiB;
constexpr size_t WS_WMD = 233 * MiB;
constexpr size_t WS_H = 289 * MiB;
constexpr size_t WS_XY = 401 * MiB;
static_assert(WS_Z + (size_t)MT * ZP * 2 <= WS_GQ && WS_GQ + (size_t)MT * 3072 <= WS_VT && WS_VT + (size_t)BATCH * 8 * 64 * VT_LD * 2 <= WS_R && WS_R + (size_t)32 * MiB <= WS_PART && WS_XY + (size_t)67584 * 1024 * 2 <= WS_PART && WS_PART + (size_t)11 * MC * D * 4 <= WS_END && WS_H + (size_t)16384 * 3584 * 2 <= WS_XY && WS_G + (size_t)MT * DFF * 2 <= WS_VT, "ws map");
constexpr int CW_TMO = 0, CW_BAR = 4096, CW_CNT = 8192;

constexpr int RING_BYTES = 131072, LDSCTL_OFF = RING_BYTES, MISC_OFF = LDSCTL_OFF + 320, LDS_BYTES = 147456;
constexpr int NWAVES = 8;

__device__ __forceinline__ int fresh_s(int v) { asm volatile("" : "+s"(v)); return v; }
__device__ __forceinline__ int fresh_tid() { int t = threadIdx.x; asm volatile("" : "+v"(t)); return t; }
__device__ __forceinline__ unsigned pk2(float lo, float hi) { f32x2 v = {lo, hi}; bf16x2_t b = __builtin_convertvector(v, bf16x2_t); return __builtin_bit_cast(unsigned, b); }
__device__ __forceinline__ float bflo(unsigned w) { return __uint_as_float(w << 16); }
__device__ __forceinline__ float bfhi(unsigned w) { return __uint_as_float(w & 0xffff0000u); }
__device__ __forceinline__ float bf2f(bf16 b) { return __uint_as_float(((unsigned)b) << 16); }
__device__ __forceinline__ float fast_exp2(float x) { return __builtin_amdgcn_exp2f(x); }
__device__ __forceinline__ float sigmoidf_(float x) { return __builtin_amdgcn_rcpf(1.0f + __builtin_amdgcn_exp2f(-1.44269504088896f * x)); }

#ifndef RELAX_EPI
#define RELAX_EPI 0
#endif
namespace pg8 {
constexpr int BM = 256, BK = 64, HALF = 128, HTB = HALF * BK * 2, STAGE_BYTES = 8 * HTB, NXCD = 8, WGM = 8;
__host__ __device__ __forceinline__ int lds_byte(int r, int c) { const int st = (r >> 4) * 2 + (c >> 5), rr = r & 15, cc = c & 31, ob = rr * 64 + cc * 2; return st * 1024 + (ob ^ (((ob >> 9) & 1) << 5)); }
__host__ __device__ __forceinline__ void stage_rc(int b, int& R, int& C) { const int st = b / 1024, sb = b % 1024, swz = sb ^ (((sb >> 9) & 1) << 5); R = (st >> 1) * 16 + swz / 64; C = (st & 1) * 32 + (swz % 64) / 2; }
__host__ __device__ __forceinline__ int perm32(int rho) { const int n = rho >> 4, i = rho & 15; return 8 * (i >> 2) + 4 * n + (i & 3); }

struct Unit { int pm, pn; const char* A; const char* B; int nt; int aux; };
struct Gemm { int lda, ldb; };

__device__ __forceinline__ bool tile_map(long L, int nM, int nN, int& pm, int& pn) {
    const int nwg = nM * nN; if (L >= nwg) return false;
    int wgid = (int)L; { const int q = nwg / NXCD, r = nwg % NXCD, xcd = wgid % NXCD, off = wgid / NXCD; wgid = (xcd < r ? xcd * (q + 1) : r * (q + 1) + (xcd - r) * q) + off; }
    const int nig = WGM * nN, gid = wgid / nig, fm = gid * WGM, gsz = (nM - fm) < WGM ? (nM - fm) : WGM;
    pm = fm + ((wgid % nig) % gsz); pn = (wgid % nig) / gsz; return true;
}

template <class Epi, class Sched, bool ALIGN_EPI = true, bool SP2 = true>
__device__ __forceinline__ void gemm_phase(LAS unsigned char* lds, const Gemm g, const Sched& S, const Epi& E) {
    const int tid = fresh_tid(), wid = __builtin_amdgcn_readfirstlane(tid >> 6), lane = tid & 63, wr = wid >> 2, wc = wid & 3, fr = lane & 15, fq = lane >> 4;
    unsigned voffA[2], voffB[2];
#pragma unroll
    for (int i = 0; i < 2; ++i) { int R, C; stage_rc(tid * 16 + i * 8192, R, C); const int Rb = Epi::PERM ? ((R & ~31) + perm32(R & 31)) : R;
        voffA[i] = (unsigned)(R * g.lda + C) * 2u; voffB[i] = (unsigned)(Rb * g.ldb + C) * 2u; }
    const size_t kstep = (size_t)(BK * 2);
    const size_t hstepA = (size_t)HALF * g.lda * 2, hstepB = (size_t)HALF * g.ldb * 2;
    const unsigned ldsw = (unsigned)wid * 1024u;
    const int aoff = lds_byte(wr * 64 + fr, fq * 8), boff = lds_byte(wc * 32 + fr, fq * 8);
#define PG8_SA(b, h) (((b) * 2 + (h)) * HTB)
#define PG8_SB(b, h) ((4 + (b) * 2 + (h)) * HTB)
#define PG8_STAGE(bufoff, gbase, voff) do { _Pragma("unroll") for (int _i = 0; _i < 2; ++_i) \
        __builtin_amdgcn_global_load_lds((const unsigned*)((const char*)(gbase) + (voff)[_i]), (LAS unsigned*)(lds + (bufoff) + ldsw + _i * 8192), 16, 0, 0); } while (0)
#define PG8_LDA(dst, b, h) do { _Pragma("unroll") for (int m = 0; m < 4; ++m) _Pragma("unroll") for (int k = 0; k < 2; ++k) dst[m][k] = *(const LAS bf16x8*)(lds + PG8_SA(b, h) + aoff + m * 2048 + k * 1024); } while (0)
#define PG8_LDB(dst, b, h) do { _Pragma("unroll") for (int n = 0; n < 2; ++n) _Pragma("unroll") for (int k = 0; k < 2; ++k) dst[n][k] = *(const LAS bf16x8*)(lds + PG8_SB(b, h) + boff + n * 2048 + k * 1024); } while (0)
#define PG8_MMA(ai, bj, At, Bt) do { __builtin_amdgcn_s_setprio(1); _Pragma("unroll") for (int m = 0; m < 4; ++m) _Pragma("unroll") for (int n = 0; n < 2; ++n) _Pragma("unroll") for (int k = 0; k < 2; ++k) \
        acc[ai][bj][m][n] = __builtin_amdgcn_mfma_f32_16x16x32_bf16(Bt[n][k], At[m][k], acc[ai][bj][m][n], 0, 0, 0); __builtin_amdgcn_s_setprio(0); } while (0)
#define PG8_WAIT_V(n) asm volatile("s_waitcnt vmcnt(" #n ")" ::: "memory")
#define PG8_WAIT_L(n) asm volatile("s_waitcnt lgkmcnt(" #n ")" ::: "memory")
#define PG8_WAIT_VX(strict_) do { if constexpr (Epi::NST == 8) asm volatile("s_cmp_eq_u32 %0, 0\n\ts_cbranch_scc1 .Lrx_%=\n\ts_waitcnt vmcnt(8)\n.Lrx_%=:\n\ts_waitcnt vmcnt(16)" :: "s"(strict_) : "memory", "scc"); \
        else if constexpr (Epi::NST == 16) asm volatile("s_cmp_eq_u32 %0, 0\n\ts_cbranch_scc1 .Lrx_%=\n\ts_waitcnt vmcnt(8)\n.Lrx_%=:\n\ts_waitcnt vmcnt(24)" :: "s"(strict_) : "memory", "scc"); \
        else asm volatile("s_waitcnt vmcnt(8)" ::: "memory"); } while (0)
#define PG8_BAR __builtin_amdgcn_s_barrier()
#define PG8_SCHED __builtin_amdgcn_sched_barrier(0)
    Unit cur, nxt; int ui = 0;
    if (!S.next(0, cur)) return;
    f32x4 acc[2][2][4][2];
#pragma unroll
    for (int a = 0; a < 2; ++a)
#pragma unroll
        for (int b = 0; b < 2; ++b)
#pragma unroll
            for (int m = 0; m < 4; ++m)
#pragma unroll
                for (int n = 0; n < 2; ++n) acc[a][b][m][n] = (f32x4){0.f, 0.f, 0.f, 0.f};
    bf16x8 At[4][2], B0[2][2], B1[2][2];
    const char* cA = cur.A; const char* cB = cur.B;
    if constexpr (SP2) {
        PG8_STAGE(PG8_SB(0, 0), cB, voffB); PG8_STAGE(PG8_SB(0, 1), cB + hstepB, voffB); PG8_STAGE(PG8_SA(0, 0), cA, voffA); PG8_STAGE(PG8_SA(0, 1), cA + hstepA, voffA);
        if (wr == 1) PG8_BAR;
        PG8_WAIT_V(2); PG8_BAR;
        PG8_STAGE(PG8_SB(1, 0), cB + kstep, voffB); PG8_STAGE(PG8_SA(1, 0), cA + kstep, voffA); PG8_STAGE(PG8_SB(1, 1), cB + hstepB + kstep, voffB);
        PG8_WAIT_V(6); PG8_BAR;
    } else {
        PG8_STAGE(PG8_SB(0, 0), cB, voffB); PG8_STAGE(PG8_SA(0, 0), cA, voffA); PG8_STAGE(PG8_SB(0, 1), cB + hstepB, voffB); PG8_STAGE(PG8_SA(0, 1), cA + hstepA, voffA);
        if (wr == 1) PG8_BAR;
        PG8_WAIT_V(4); PG8_BAR;
        PG8_STAGE(PG8_SB(1, 0), cB + kstep, voffB); PG8_STAGE(PG8_SA(1, 0), cA + kstep, voffA); PG8_STAGE(PG8_SB(1, 1), cB + hstepB + kstep, voffB);
        PG8_WAIT_V(6); PG8_BAR;
    }
    for (;;) {
        const bool has_next = S.next(ui + 1, nxt);
        const char* nA = has_next ? nxt.A : cA; const char* nB = has_next ? nxt.B : cB;
        const int nt = cur.nt;
#define PG8_TRIP(tt, WA, WB) do { const bool last = ((tt) == nt - 2); PG8_SCHED; \
            const char* a1 = cA + (size_t)((tt) + 1) * kstep; \
            const char* a2 = last ? nA : cA + (size_t)((tt) + 2) * kstep; const char* b2 = last ? nB : cB + (size_t)((tt) + 2) * kstep; \
            const char* a3 = a2 + kstep; const char* b3 = b2 + kstep; \
            PG8_LDB(B0, 0, 0); PG8_LDB(B1, 0, 1); PG8_SCHED; PG8_LDA(At, 0, 0); PG8_STAGE(PG8_SA(1, 1), a1 + hstepA, voffA); \
            WA; PG8_WAIT_L(0); PG8_BAR; PG8_MMA(0, 0, At, B0); PG8_MMA(0, 1, At, B1); PG8_BAR; PG8_SCHED; \
            PG8_LDA(At, 0, 1); PG8_STAGE(PG8_SB(0, 0), b2, voffB); PG8_STAGE(PG8_SB(0, 1), b2 + hstepB, voffB); PG8_STAGE(PG8_SA(0, 0), a2, voffA); \
            WB; PG8_WAIT_L(0); PG8_BAR; PG8_MMA(1, 0, At, B0); PG8_MMA(1, 1, At, B1); PG8_BAR; PG8_SCHED; \
            PG8_LDB(B0, 1, 0); PG8_LDB(B1, 1, 1); PG8_SCHED; PG8_LDA(At, 1, 0); PG8_STAGE(PG8_SA(0, 1), a2 + hstepA, voffA); \
            PG8_WAIT_V(8); PG8_WAIT_L(0); PG8_BAR; PG8_MMA(0, 0, At, B0); PG8_MMA(0, 1, At, B1); PG8_BAR; PG8_SCHED; \
            PG8_LDA(At, 1, 1); PG8_STAGE(PG8_SB(1, 0), b3, voffB); PG8_STAGE(PG8_SB(1, 1), b3 + hstepB, voffB); PG8_STAGE(PG8_SA(1, 0), a3, voffA); \
            PG8_WAIT_V(8); PG8_WAIT_L(0); PG8_BAR; PG8_MMA(1, 0, At, B0); PG8_MMA(1, 1, At, B1); PG8_BAR; PG8_SCHED; } while (0)
        for (int t = 0; t < nt; t += 2) { const int strict = __builtin_amdgcn_readfirstlane((RELAX_EPI && Epi::NST > 0 && t == 0 && ui > 0) ? 0 : 1);
            PG8_TRIP(t, PG8_WAIT_VX(strict), PG8_WAIT_VX(strict)); }
#undef PG8_TRIP
        if constexpr (ALIGN_EPI) { if (wr == 0) PG8_BAR; }
        E(acc, cur, wr, wc, fr, fq);
        if (!has_next) break;
        if (E.zero_after(cur)) {
#pragma unroll
            for (int a = 0; a < 2; ++a)
#pragma unroll
                for (int b = 0; b < 2; ++b)
#pragma unroll
                    for (int m = 0; m < 4; ++m)
#pragma unroll
                        for (int n = 0; n < 2; ++n) acc[a][b][m][n] = (f32x4){0.f, 0.f, 0.f, 0.f};
        }
        cur = nxt; cA = nA; cB = nB; ++ui;
        if constexpr (ALIGN_EPI) { if (wr == 1) PG8_BAR; }
    }
    PG8_WAIT_V(0);
    if constexpr (!ALIGN_EPI) { if (wr == 0) PG8_BAR; }
    PG8_BAR;
#undef PG8_SA
#undef PG8_SB
#undef PG8_STAGE
#undef PG8_LDA
#undef PG8_LDB
#undef PG8_MMA
#undef PG8_WAIT_V
#undef PG8_WAIT_L
#undef PG8_WAIT_VX
#undef PG8_BAR
#undef PG8_SCHED
}

struct SchedPlain {
    int nM, nN, G, c, nt; const char* A; const char* B; size_t tsA, tsB;
    __device__ __forceinline__ void init(int M, int N, int K, const bf16* A_, int lda, const bf16* B_, int ldb, int G_, int c_) {
        nM = M / BM; nN = N / BM; G = G_; c = c_; nt = K / BK; A = (const char*)A_; B = (const char*)B_; tsA = (size_t)BM * lda * 2; tsB = (size_t)BM * ldb * 2; }
    __device__ __forceinline__ bool next(int i, Unit& u) const {
        if (!tile_map((long)i * G + c, nM, nN, u.pm, u.pn)) return false;
        u.A = A + (size_t)u.pm * tsA; u.B = B + (size_t)u.pn * tsB; u.nt = nt; u.aux = 0; return true; }
};
struct SchedMerge {
    int nM, G, c; const char* Z; const char* W;
    __device__ __forceinline__ bool next(int i, Unit& u) const {
        const int ii = i / 3, br = i - 3 * ii;
        if (!tile_map((long)ii * G + c, nM, 4, u.pm, u.pn)) return false;
        const int acol = br == 0 ? 0 : (br == 1 ? Q_OFF : B_OFF), kof = br == 0 ? 0 : (br == 1 ? 256 : 768);
        u.A = Z + ((size_t)u.pm * BM * ZP + acol) * 2; u.B = W + ((size_t)u.pn * BM * D + kof) * 2; u.nt = br == 1 ? 8 : 4; u.aux = br; return true; }
};
struct MoeTiles { int pre[NE + 1]; };
__device__ __forceinline__ int moe_expert(const MoeTiles& T, int tile) { int e = 0;
#pragma unroll
    for (int j = 1; j < NE; ++j) e += (tile >= T.pre[j]) ? 1 : 0; return e; }
struct SchedMoeUp {
    MoeTiles T; int t0, ntc, G, c; const char* X; const char* W;
    __device__ __forceinline__ bool next(int i, Unit& u) const {
        int pml; if (!tile_map((long)i * G + c, ntc, 28, pml, u.pn)) return false;
        const int tile = t0 + pml, e = moe_expert(T, tile);
        u.pm = pml; u.A = X + (size_t)tile * BM * D * 2; u.B = W + ((size_t)e * 7168 + (size_t)u.pn * BM) * D * 2; u.nt = 16; u.aux = 0; return true; }
};
struct SchedMoeDown {
    MoeTiles T; int t0, ntc, nsl, G, c; const char* H; const char* W;
    __device__ __forceinline__ bool next(int i, Unit& u) const {
        const long L = (long)i * G + c; const int per = ntc * 4; if (L >= (long)per * nsl) return false;
        const int sl = (int)(L / per); int pml; tile_map(L - (long)sl * per, ntc, 4, pml, u.pn);
        const int tile = t0 + pml, e = moe_expert(T, tile), ntk = 56 / nsl;
        u.pm = (nsl == 1) ? tile : 8 * sl + pml; u.nt = ntk; u.aux = sl;
        u.A = H + (size_t)pml * BM * DFE * 2 + (size_t)sl * ntk * 128; u.B = W + ((size_t)e * D + (size_t)u.pn * BM) * DFE * 2 + (size_t)sl * ntk * 128; return true; }
};

struct EpiInProj {
    static constexpr bool PERM = true; static constexpr int NST = 16;
    bf16* Z; bf16* VT; unsigned char* GQ;
    __device__ __forceinline__ bool zero_after(const Unit&) const { return true; }
    __device__ __forceinline__ void operator()(f32x4 (&acc)[2][2][4][2], const Unit& u, int wr, int wc, int fr_, int fq_) const {
        int fr = fr_, fq = fq_; asm volatile("" : "+v"(fr), "+v"(fq));
        const int row0 = u.pm * BM + wr * 64 + fr, col0 = u.pn * BM + wc * 32 + 8 * fq;
        const int kind = (u.pn == 1 || u.pn == 2) ? 1 : ((u.pn == 5 || u.pn == 6) ? 2 : (u.pn >= 10 ? 3 : 0));
        if (kind == 2) {
#pragma unroll
            for (int ai = 0; ai < 2; ++ai)
#pragma unroll
                for (int m = 0; m < 4; ++m) { const int row = row0 + ai * HALF + m * 16;
                    const int b = row < ML ? (row >> 13) : ((row - ML) >> 8), t = row < ML ? (row & 8191) : (SEQ + ((row - ML) & 255));
#pragma unroll
                    for (int bj = 0; bj < 2; ++bj)
#pragma unroll
                        for (int n = 0; n < 2; ++n)
#pragma unroll
                            for (int j = 0; j < 4; ++j) { const int vc = col0 + bj * HALF + 4 * n + j - V_OFF;
                                VT[((size_t)(b * 512 + vc)) * VT_LD + t] = (bf16)(pk2(acc[ai][bj][m][n][j], 0.f) & 0xffffu); } }
            return;
        }
        if (kind == 3) {
            unsigned char* gq_tile = GQ + ((size_t)(u.pm * 12 + (u.pn - 10)) * 8 + (wr * 4 + wc)) * 8192 + (fq * 16 + fr) * 8;
#pragma unroll
            for (int ai = 0; ai < 2; ++ai)
#pragma unroll
                for (int m = 0; m < 4; ++m) { unsigned char* rowp = gq_tile + ((ai * 4 + m) * 2) * 512;
#pragma unroll
                    for (int bj = 0; bj < 2; ++bj) { u32x2 w; w.x = 0u; w.y = 0u;
#pragma unroll
                        for (int j = 0; j < 4; ++j) { w.x |= (unsigned)(sigmoidf_(acc[ai][bj][m][0][j]) * 255.0f + 0.5f) << (8 * j); w.y |= (unsigned)(sigmoidf_(acc[ai][bj][m][1][j]) * 255.0f + 0.5f) << (8 * j); }
                        *(u32x2*)(rowp + bj * 512) = w; } }
            return;
        }
        const float qs = 0.125f * 1.44269504088896f;
#pragma unroll
        for (int ai = 0; ai < 2; ++ai)
#pragma unroll
            for (int m = 0; m < 4; ++m) { bf16* rowp = Z + (size_t)(row0 + ai * HALF + m * 16) * ZP + col0;
#pragma unroll
                for (int bj = 0; bj < 2; ++bj) { f32x4 v0 = acc[ai][bj][m][0], v1 = acc[ai][bj][m][1];
                    if (kind == 1) { v0 = v0 * qs; v1 = v1 * qs; }
                    u32x4 w; w.x = pk2(v0[0], v0[1]); w.y = pk2(v0[2], v0[3]); w.z = pk2(v1[0], v1[1]); w.w = pk2(v1[2], v1[3]);
                    *(u32x4*)(rowp + bj * HALF) = w; } }
    }
};
struct EpiMerge {
    static constexpr bool PERM = true; static constexpr int NST = 0;
    const unsigned char* GQ; bf16* O;
    __device__ __forceinline__ bool zero_after(const Unit& u) const { return u.aux == 2; }
    __device__ __forceinline__ void operator()(f32x4 (&acc)[2][2][4][2], const Unit& u, int wr, int wc, int fr_, int fq_) const {
        int fr = fr_, fq = fq_; asm volatile("" : "+v"(fr), "+v"(fq));
        const int row0 = u.pm * BM + wr * 64 + fr, col0 = u.pn * BM + wc * 32 + 8 * fq, br = u.aux;
        const unsigned char* gq_t = GQ + ((size_t)(u.pm * 12 + u.pn) * 8 + (wr * 4 + wc)) * 8192 + (fq * 16 + fr) * 8;
        u32x2 gc[16], gn[16];
#pragma unroll
        for (int i = 0; i < 16; ++i) { gc[i] = *(const u32x2*)(gq_t + (size_t)br * 4 * 65536 + i * 512); gn[i] = (br < 2) ? *(const u32x2*)(gq_t + (size_t)(br + 1) * 4 * 65536 + i * 512) : gc[i]; }
#pragma unroll
        for (int ai = 0; ai < 2; ++ai)
#pragma unroll
            for (int m = 0; m < 4; ++m) { const size_t row = (size_t)(row0 + ai * HALF + m * 16);
#pragma unroll
                for (int bj = 0; bj < 2; ++bj) { const int col = col0 + bj * HALF, i = (ai * 4 + m) * 2 + bj;
                    float f[8];
#pragma unroll
                    for (int j = 0; j < 4; ++j) { f[j] = fmaxf((float)((gc[i].x >> (8 * j)) & 255u), 0.5f); f[4 + j] = fmaxf((float)((gc[i].y >> (8 * j)) & 255u), 0.5f); }
                    if (br < 2) {
#pragma unroll
                        for (int j = 0; j < 4; ++j) { f[j] *= __builtin_amdgcn_rcpf(fmaxf((float)((gn[i].x >> (8 * j)) & 255u), 0.5f)); f[4 + j] *= __builtin_amdgcn_rcpf(fmaxf((float)((gn[i].y >> (8 * j)) & 255u), 0.5f)); } }
                    else {
#pragma unroll
                        for (int j = 0; j < 8; ++j) f[j] *= (1.0f / 255.0f); }
#pragma unroll
                    for (int j = 0; j < 4; ++j) { acc[ai][bj][m][0][j] *= f[j]; acc[ai][bj][m][1][j] *= f[4 + j]; }
                    if (br == 2) { const f32x4 v0 = acc[ai][bj][m][0], v1 = acc[ai][bj][m][1];
                        u32x4 w; w.x = pk2(v0[0], v0[1]); w.y = pk2(v0[2], v0[3]); w.z = pk2(v1[0], v1[1]); w.w = pk2(v1[2], v1[3]);
                        *(u32x4*)(O + row * D + col) = w; } } }
    }
};
struct EpiResid {
    static constexpr bool PERM = false; static constexpr int NST = 16;
    const float* xl_in; const float* xc_in; float* xl_out; float* xc_out; const float* gate; float* part;
    __device__ __forceinline__ bool zero_after(const Unit&) const { return true; }
    __device__ __forceinline__ void operator()(f32x4 (&acc)[2][2][4][2], const Unit& u, int wr, int wc, int fr_, int fq_) const {
        int fr = fr_, fq = fq_; asm volatile("" : "+v"(fr), "+v"(fq));
        const int rt = u.pm * BM, col0 = u.pn * BM + wc * 32 + 4 * fq;
        const bool lat = rt < ML; const int v = lat ? (rt >> 13) : 4;
        const float* xin = lat ? xl_in + (size_t)rt * D : xc_in + (size_t)(rt - ML) * D; float* xout = lat ? xl_out + (size_t)rt * D : xc_out + (size_t)(rt - ML) * D;
        f32x4 gv[2][2];
#pragma unroll
        for (int bj = 0; bj < 2; ++bj)
#pragma unroll
            for (int n = 0; n < 2; ++n) gv[bj][n] = *(const f32x4*)(gate + (size_t)v * NMOD + col0 + bj * HALF + n * 16);
        if (u.aux > 0) {
            float* po = part + ((size_t)(u.aux - 1) * MC + (rt - ML)) * D;
#pragma unroll
            for (int ai = 0; ai < 2; ++ai)
#pragma unroll
                for (int m = 0; m < 4; ++m) { const size_t off = (size_t)(wr * 64 + fr + ai * HALF + m * 16) * D + col0;
#pragma unroll
                    for (int bj = 0; bj < 2; ++bj)
#pragma unroll
                        for (int n = 0; n < 2; ++n) *(f32x4*)(po + off + bj * HALF + n * 16) = gv[bj][n] * acc[ai][bj][m][n]; }
            return;
        }
#pragma unroll
        for (int ai = 0; ai < 2; ++ai) {
            f32x4 xi[4][2][2];
#pragma unroll
            for (int m = 0; m < 4; ++m) { const size_t off = (size_t)(wr * 64 + fr + ai * HALF + m * 16) * D + col0;
#pragma unroll
                for (int bj = 0; bj < 2; ++bj)
#pragma unroll
                    for (int n = 0; n < 2; ++n) xi[m][bj][n] = *(const f32x4*)(xin + off + bj * HALF + n * 16); }
#pragma unroll
            for (int m = 0; m < 4; ++m) { const size_t off = (size_t)(wr * 64 + fr + ai * HALF + m * 16) * D + col0;
#pragma unroll
                for (int bj = 0; bj < 2; ++bj)
#pragma unroll
                    for (int n = 0; n < 2; ++n) *(f32x4*)(xout + off + bj * HALF + n * 16) = xi[m][bj][n] + gv[bj][n] * acc[ai][bj][m][n]; }
        }
    }
};
struct SchedSplitCtx {
    int G, c, ntK, do_ctx; const char* A; const char* B; size_t tsA, tsB;
    __device__ __forceinline__ bool next(int i, Unit& u) const {
        const long L = (long)i * G + c; if (L >= 512 && !do_ctx) return false;
        if (L < 512) { tile_map(L, 128, 4, u.pm, u.pn); u.A = A + (size_t)u.pm * tsA; u.B = B + (size_t)u.pn * tsB; u.nt = ntK; u.aux = 0; return true; }
        const int j = (int)(L - 512), ns = ntK >> 2;
        if (j >= 16 * ns) return false;
        const int ks = j >> 4, tile = j & 15; u.pm = 128 + (tile >> 2); u.pn = tile & 3;
        u.A = A + (size_t)u.pm * tsA + (size_t)ks * 512; u.B = B + (size_t)u.pn * tsB + (size_t)ks * 512; u.nt = 4; u.aux = 1 + ks; return true; }
};
struct EpiSwiglu {
    static constexpr bool PERM = true; static constexpr int NST = 8;
    bf16* O; int ldo;
    __device__ __forceinline__ bool zero_after(const Unit&) const { return true; }
    __device__ __forceinline__ void operator()(f32x4 (&acc)[2][2][4][2], const Unit& u, int wr, int wc, int fr_, int fq_) const {
        int fr = fr_, fq = fq_; asm volatile("" : "+v"(fr), "+v"(fq));
        const int row0 = u.pm * BM + wr * 64 + fr, col0 = u.pn * HALF + wc * 32 + 8 * fq;
#pragma unroll
        for (int ai = 0; ai < 2; ++ai)
#pragma unroll
            for (int m = 0; m < 4; ++m) { bf16* rowp = O + (size_t)(row0 + ai * HALF + m * 16) * ldo + col0;
                float o[8];
#pragma unroll
                for (int n = 0; n < 2; ++n)
#pragma unroll
                    for (int j = 0; j < 4; ++j) { const float gt = acc[ai][0][m][n][j], up = acc[ai][1][m][n][j]; o[4 * n + j] = gt * sigmoidf_(gt) * up; }
                u32x4 w; w.x = pk2(o[0], o[1]); w.y = pk2(o[2], o[3]); w.z = pk2(o[4], o[5]); w.w = pk2(o[6], o[7]);
                *(u32x4*)rowp = w; }
    }
};
struct EpiBf16 {
    static constexpr bool PERM = true; static constexpr int NST = 16;
    bf16* O; int ldo;
    __device__ __forceinline__ bool zero_after(const Unit&) const { return true; }
    __device__ __forceinline__ void operator()(f32x4 (&acc)[2][2][4][2], const Unit& u, int wr, int wc, int fr_, int fq_) const {
        int fr = fr_, fq = fq_; asm volatile("" : "+v"(fr), "+v"(fq));
        const int row0 = u.pm * BM + wr * 64 + fr, col0 = u.pn * BM + wc * 32 + 8 * fq;
#pragma unroll
        for (int ai = 0; ai < 2; ++ai)
#pragma unroll
            for (int m = 0; m < 4; ++m) { bf16* rowp = O + (size_t)(row0 + ai * HALF + m * 16) * ldo + col0;
#pragma unroll
                for (int bj = 0; bj < 2; ++bj) { const f32x4 v0 = acc[ai][bj][m][0], v1 = acc[ai][bj][m][1];
                    u32x4 w; w.x = pk2(v0[0], v0[1]); w.y = pk2(v0[2], v0[3]); w.z = pk2(v1[0], v1[1]); w.w = pk2(v1[2], v1[3]);
                    *(u32x4*)(rowp + bj * HALF) = w; } }
    }
};
struct EpiNull {
    static constexpr bool PERM = true; static constexpr int NST = 0;
    float* sink;
    __device__ __forceinline__ bool zero_after(const Unit&) const { return true; }
    __device__ __forceinline__ void operator()(f32x4 (&acc)[2][2][4][2], const Unit& u, int wr, int wc, int fr_, int fq_) const {
        int fr = fr_, fq = fq_; asm volatile("" : "+v"(fr), "+v"(fq));
        f32x4 t = (f32x4){0.f, 0.f, 0.f, 0.f};
#pragma unroll
        for (int ai = 0; ai < 2; ++ai)
#pragma unroll
            for (int bj = 0; bj < 2; ++bj)
#pragma unroll
                for (int m = 0; m < 4; ++m)
#pragma unroll
                    for (int n = 0; n < 2; ++n) t += acc[ai][bj][m][n];
        if (t.x + t.y + t.z + t.w == 1.2345678e33f) sink[u.pm] = t.x;
    }
};
struct SchedPlainRep : SchedPlain {
    int rep;
    __device__ __forceinline__ bool next(int i, Unit& u) const {
#ifdef DUP_LONGK
        const bool ok = SchedPlain::next(i, u); u.nt *= rep; return ok;
#else
        return SchedPlain::next(i / rep, u);
#endif
    }
};
}

typedef GAS unsigned gu32;
#define RLX_AGENT __ATOMIC_RELAXED, __HIP_MEMORY_SCOPE_AGENT
#define LDS_WAIT() asm volatile("s_waitcnt lgkmcnt(0)" ::: "memory")
#define VM_WAIT() asm volatile("s_waitcnt vmcnt(0)" ::: "memory")
#define MFMA16(a, b, c) __builtin_amdgcn_mfma_f32_16x16x32_bf16((a), (b), (c), 0, 0, 0)

#define XB_TMO      128
#define XB_XCNT(j)  (256  + 64 * (j))
#define XB_XSUB(j)  (1280 + 64 * (j))
#define XB_XGEN(j)  (2304 + 64 * (j))
#define XB_TOP      3328
#define XB_TOPGEN   3392
#define XCD_BAR_WORDS 3456
#define XB_SPIN_CAP (1u << 18)
__device__ __forceinline__ unsigned xb_ld(unsigned* p)              { return __hip_atomic_load(p, __ATOMIC_RELAXED, __HIP_MEMORY_SCOPE_AGENT); }
__device__ __forceinline__ unsigned xb_add(unsigned* p, unsigned v) { return __hip_atomic_fetch_add(p, v, __ATOMIC_RELAXED, __HIP_MEMORY_SCOPE_AGENT); }
__device__ __forceinline__ unsigned xb_xcc_id() { return (unsigned)__builtin_amdgcn_s_getreg((3 << 11) | 20) & 0xFu; }
#define XB_SPIN(cond, bar) do { unsigned _sp = 0; while (cond) { __builtin_amdgcn_s_sleep(1); \
    if ((++_sp & 255u) == 0u) { if (xb_ld(&(bar)[XB_TMO])) break; if (_sp > XB_SPIN_CAP) { atomicAdd(&(bar)[XB_TMO], 1u); break; } } } } while (0)
struct XcdBarrier { unsigned* bar; unsigned x; volatile LAS unsigned* st; };
__device__ __forceinline__ XcdBarrier xcd_barrier_post(unsigned* bar, volatile LAS unsigned* st) {
    XcdBarrier b; b.bar = bar; b.x = xb_xcc_id(); b.st = st;
    if (threadIdx.x == 0) (void)xb_add(&bar[XB_XCNT(b.x)], 1u);
    return b;
}
__device__ __forceinline__ void xcd_barrier_complete(unsigned* bar, unsigned x, unsigned& nloc, unsigned& nx) {
    const unsigned G = gridDim.x * gridDim.y * gridDim.z;
    unsigned sum, cnt, mine, sp = 0u;
    for (;;) {
        sum = 0u; cnt = 0u; mine = 0u;
#pragma unroll
        for (unsigned j = 0; j < 16; ++j) { const unsigned c = xb_ld(&bar[XB_XCNT(j)]); sum += c; cnt += (c > 0u) ? 1u : 0u; mine = (j == x) ? c : mine; }
        if (sum == G) break;
        __builtin_amdgcn_s_sleep(1);
        if ((++sp & 255u) == 0u) { if (xb_ld(&bar[XB_TMO])) break; if (sp > XB_SPIN_CAP) { atomicAdd(&bar[XB_TMO], 1u); break; } }
    }
    nloc = mine > 0u ? mine : 1u; nx = cnt > 0u ? cnt : 1u;
}
__device__ __forceinline__ void xcd_barrier(const XcdBarrier& b) {
    asm volatile("s_waitcnt vmcnt(0)" ::: "memory");
    __syncthreads();
    if (threadIdx.x == 0) {
        unsigned* bar = b.bar; unsigned bx_ = b.x;
        asm volatile("" : "+s"(bar), "+s"(bx_));
        __builtin_amdgcn_s_waitcnt(0);
        unsigned nloc = b.st[0], nx = b.st[1];
        if (nloc == 0u) { xcd_barrier_complete(bar, bx_, nloc, nx); b.st[0] = nloc; b.st[1] = nx; }
        const unsigned old = xb_add(&bar[XB_XSUB(bx_)], 1u);
        const unsigned gen = old / nloc;
        if (old + 1u == (gen + 1u) * nloc) {
            __builtin_amdgcn_fence(__ATOMIC_RELEASE, "agent");
            asm volatile("s_waitcnt vmcnt(0)" ::: "memory");
            const unsigned og = xb_add(&bar[XB_TOP], 1u);
            const unsigned tg = og / nx;
            if (og + 1u == (tg + 1u) * nx) xb_add(&bar[XB_TOPGEN], 1u);
            else XB_SPIN(xb_ld(&bar[XB_TOPGEN]) == tg, bar);
            __builtin_amdgcn_fence(__ATOMIC_ACQUIRE, "agent");
            xb_add(&bar[XB_XGEN(bx_)], 1u);
            asm volatile("s_waitcnt vmcnt(0)" ::: "memory");
        } else {
            XB_SPIN(xb_ld(&bar[XB_XGEN(bx_)]) == gen, bar);
            __builtin_amdgcn_fence(__ATOMIC_ACQUIRE, "agent");
            asm volatile("s_waitcnt vmcnt(0)" ::: "memory");
        }
    }
    __syncthreads();
}

__device__ __forceinline__ float shx(float v, int o, int lane) { return __int_as_float(__builtin_amdgcn_ds_bpermute((lane ^ o) << 2, __float_as_int(v))); }
__device__ __forceinline__ float wave_sum(float v, int lane) {
#pragma unroll
    for (int o = 1; o < 64; o <<= 1) v += shx(v, o, lane);
    return v;
}

__device__ __forceinline__ void transpose_item(const float* W, int N, bf16* WT, int ldk, int dst_row0, int dst_k0, int k0, int n0, LAS float* scr, int lane) {
    f32x4 v[8];
#pragma unroll
    for (int i = 0; i < 8; ++i) v[i] = *(const f32x4*)(W + (size_t)(k0 + (lane >> 3) + 8 * i) * N + n0 + 4 * (lane & 7));
#pragma unroll
    for (int i = 0; i < 8; ++i) { LAS float* d = scr + ((lane >> 3) + 8 * i) * 33 + 4 * (lane & 7); d[0] = v[i].x; d[1] = v[i].y; d[2] = v[i].z; d[3] = v[i].w; }
    LDS_WAIT(); asm volatile("" ::: "memory");
    const int c = lane & 7;
#pragma unroll
    for (int j = 0; j < 4; ++j) { const int n = (lane >> 3) + 8 * j; const LAS float* s = scr + (8 * c) * 33 + n;
        u32x4 o; o.x = pk2(s[0 * 33], s[1 * 33]); o.y = pk2(s[2 * 33], s[3 * 33]); o.z = pk2(s[4 * 33], s[5 * 33]); o.w = pk2(s[6 * 33], s[7 * 33]);
        *(u32x4*)(WT + (size_t)(dst_row0 + n) * ldk + dst_k0 + k0 + 8 * c) = o; }
    LDS_WAIT(); asm volatile("" ::: "memory");
}
__device__ __forceinline__ void tr_matrix(const float* W, int K, int N, bf16* WT, int ldk, int dst_k0, int mode, int& base, int gw, int NGW, LAS float* scr, int lane) {
    const int nnb = N / 32, items = (K / 64) * nnb;
    const int first = (gw - base % NGW + NGW) % NGW;
    for (int it = first; it < items; it += NGW) { const int kb = it / nnb, nb = it - kb * nnb, n0 = 32 * nb;
        const int dr = mode == 0 ? n0 : (256 * (n0 >> 7) + (n0 & 127) + (mode == 2 ? 128 : 0));
        transpose_item(W, N, WT, ldk, dr, dst_k0, 64 * kb, n0, scr, lane); }
    base += items;
}

__device__ __forceinline__ void norm_row(const float* xrow, const float* g, const float* shift, const float* scale, bf16* orow, int lane, f32x4 (&hv)[4]) {
    f32x4 v[4]; float s = 0.f;
#pragma unroll
    for (int j = 0; j < 4; ++j) { v[j] = *(const f32x4*)(xrow + 4 * lane + 256 * j); s += (v[j].x * v[j].x + v[j].y * v[j].y) + (v[j].z * v[j].z + v[j].w * v[j].w); }
    const float rstd = 1.0f / sqrtf(wave_sum(s, lane) * (1.f / D) + EPS);
#pragma unroll
    for (int j = 0; j < 4; ++j) { const int o = 4 * lane + 256 * j;
        const f32x4 gg = *(const f32x4*)(g + o), sh = *(const f32x4*)(shift + o), sc = *(const f32x4*)(scale + o);
        hv[j] = v[j] * rstd * gg * (sc + 1.0f) + sh;
        u32x2 w; w.x = pk2(hv[j].x, hv[j].y); w.y = pk2(hv[j].z, hv[j].w);
        *(u32x2*)(orow + o) = w; }
}

__device__ __forceinline__ void norm_tables(LAS float* A, LAS float* S, const float* g, const float* mod, int shift_off, int scale_off, int tid) {
    for (int i = tid; i < 5 * D; i += NWAVES * 64) { const int v = i >> 10, k = i & 1023; A[i] = g[k] * (1.0f + mod[(size_t)v * NMOD + scale_off + k]); S[i] = mod[(size_t)v * NMOD + shift_off + k]; }
}
__device__ __forceinline__ void norm_load2(const float* x0, const float* x1, int lane, f32x4 (&v0)[4], f32x4 (&v1)[4]) {
#pragma unroll
    for (int j = 0; j < 4; ++j) { v0[j] = *(const f32x4*)(x0 + 4 * lane + 256 * j); v1[j] = *(const f32x4*)(x1 + 4 * lane + 256 * j); }
}
__device__ __forceinline__ void norm_finish2(const f32x4 (&v0)[4], const f32x4 (&v1)[4], LAS const float* A0, LAS const float* S0, LAS const float* A1, LAS const float* S1, bf16* o0, bf16* o1, bool st1, int lane,
                                             f32x4 (&h0)[4], f32x4 (&h1)[4]) {
    float s0 = 0.f, s1 = 0.f;
#pragma unroll
    for (int j = 0; j < 4; ++j) { s0 += (v0[j].x * v0[j].x + v0[j].y * v0[j].y) + (v0[j].z * v0[j].z + v0[j].w * v0[j].w); s1 += (v1[j].x * v1[j].x + v1[j].y * v1[j].y) + (v1[j].z * v1[j].z + v1[j].w * v1[j].w); }
#pragma unroll
    for (int o = 1; o < 64; o <<= 1) { s0 += shx(s0, o, lane); s1 += shx(s1, o, lane); }
    const float r0 = 1.0f / sqrtf(s0 * (1.f / D) + EPS), r1 = 1.0f / sqrtf(s1 * (1.f / D) + EPS);
#pragma unroll
    for (int j = 0; j < 4; ++j) { const int o = 4 * lane + 256 * j;
        h0[j] = v0[j] * r0 * *(const LAS f32x4*)(A0 + o) + *(const LAS f32x4*)(S0 + o);
        h1[j] = v1[j] * r1 * *(const LAS f32x4*)(A1 + o) + *(const LAS f32x4*)(S1 + o);
        u32x2 w; w.x = pk2(h0[j].x, h0[j].y); w.y = pk2(h0[j].z, h0[j].w); *(u32x2*)(o0 + o) = w;
        if (st1) { u32x2 w1; w1.x = pk2(h1[j].x, h1[j].y); w1.y = pk2(h1[j].z, h1[j].w); *(u32x2*)(o1 + o) = w1; } }
}
__device__ __forceinline__ void norm_rows2(const float* x0, const float* x1, LAS const float* A0, LAS const float* S0, LAS const float* A1, LAS const float* S1, bf16* o0, bf16* o1, bool st1, int lane,
                                           f32x4 (&h0)[4], f32x4 (&h1)[4]) {
    f32x4 v0[4], v1[4]; norm_load2(x0, x1, lane, v0, v1); norm_finish2(v0, v1, A0, S0, A1, S1, o0, o1, st1, lane, h0, h1);
}
template <int NA, int NB>
__device__ __forceinline__ void norm_ctx_rows(const float* xc, const float* partA, const float* partB, LAS const float* TA_, LAS const float* TS_, bf16* HX, int gw, int NGW, int lane) {
    for (int r = gw; r < MC; r += NGW) {
        f32x4 v[4], pa[NA > 0 ? NA : 1][4], pb[NB > 0 ? NB : 1][4];
#pragma unroll
        for (int j = 0; j < 4; ++j) v[j] = *(const f32x4*)(xc + (size_t)r * D + 4 * lane + 256 * j);
#pragma unroll
        for (int p = 0; p < NA; ++p)
#pragma unroll
            for (int j = 0; j < 4; ++j) pa[p][j] = *(const f32x4*)(partA + ((size_t)p * MC + r) * D + 4 * lane + 256 * j);
#pragma unroll
        for (int p = 0; p < NB; ++p)
#pragma unroll
            for (int j = 0; j < 4; ++j) pb[p][j] = *(const f32x4*)(partB + ((size_t)p * MC + r) * D + 4 * lane + 256 * j);
#pragma unroll
        for (int p = 0; p < NA; ++p)
#pragma unroll
            for (int j = 0; j < 4; ++j) v[j] += pa[p][j];
#pragma unroll
        for (int p = 0; p < NB; ++p)
#pragma unroll
            for (int j = 0; j < 4; ++j) v[j] += pb[p][j];
        f32x4 h0[4], h1[4]; norm_finish2(v, v, TA_ + 4 * D, TS_ + 4 * D, TA_ + 4 * D, TS_ + 4 * D, HX + (size_t)(ML + r) * D, HX + (size_t)(ML + r) * D, false, lane, h0, h1);
    }
}
__device__ __forceinline__ void norm_phase_rows(const float* xl, const float* xc, int M, LAS const float* TA_, LAS const float* TS_, bf16* HX, int gw, int NGW, int lane) {
    f32x4 va[4], vb[4];
    { const int row = gw, rowb = (row + NGW < M) ? row + NGW : row;
      if (row < M) norm_load2(row < ML ? xl + (size_t)row * D : xc + (size_t)(row - ML) * D, rowb < ML ? xl + (size_t)rowb * D : xc + (size_t)(rowb - ML) * D, lane, va, vb); }
    for (int row = gw; row < M; row += 2 * NGW) { const int row1 = row + NGW; const bool has1 = row1 < M; const int rowb = has1 ? row1 : row;
        const int va_ = row < ML ? (row >> 13) : 4, vb_ = rowb < ML ? (rowb >> 13) : 4;
        f32x4 na[4], nb[4]; const int nrow = row + 2 * NGW;
        if (nrow < M) { const int nrowb = (nrow + NGW < M) ? nrow + NGW : nrow;
            norm_load2(nrow < ML ? xl + (size_t)nrow * D : xc + (size_t)(nrow - ML) * D, nrowb < ML ? xl + (size_t)nrowb * D : xc + (size_t)(nrowb - ML) * D, lane, na, nb); }
        else {
#pragma unroll
            for (int j = 0; j < 4; ++j) { na[j] = va[j]; nb[j] = vb[j]; } }
        f32x4 ha[4], hb[4]; norm_finish2(va, vb, TA_ + va_ * D, TS_ + va_ * D, TA_ + vb_ * D, TS_ + vb_ * D, HX + (size_t)row * D, HX + (size_t)rowb * D, has1, lane, ha, hb);
#pragma unroll
        for (int j = 0; j < 4; ++j) { va[j] = na[j]; vb[j] = nb[j]; }
    }
}

template <typename T> __device__ __forceinline__ T ldg_u(const void* ubase, unsigned voff) { return *(const T*)((const char*)ubase + voff); }
#define RFL(x) __builtin_amdgcn_readfirstlane(x)
typedef __amdgpu_buffer_rsrc_t rsrc_t;
__device__ __forceinline__ float quad_max(float v) {
    { auto rr = __builtin_amdgcn_permlane16_swap(__float_as_uint(v), __float_as_uint(v), false, false); v = fmaxf(__uint_as_float(rr[0]), __uint_as_float(rr[1])); }
    { auto rr = __builtin_amdgcn_permlane32_swap(__float_as_uint(v), __float_as_uint(v), false, false); v = fmaxf(__uint_as_float(rr[0]), __uint_as_float(rr[1])); }
    return v; }
__device__ __forceinline__ float quad_sum(float v) {
    { auto rr = __builtin_amdgcn_permlane16_swap(__float_as_uint(v), __float_as_uint(v), false, false); v = __uint_as_float(rr[0]) + __uint_as_float(rr[1]); }
    { auto rr = __builtin_amdgcn_permlane32_swap(__float_as_uint(v), __float_as_uint(v), false, false); v = __uint_as_float(rr[0]) + __uint_as_float(rr[1]); }
    return v; }
__device__ __forceinline__ bf16x8 bld128(rsrc_t rs, unsigned voff, int soff) { return __builtin_bit_cast(bf16x8, __builtin_amdgcn_raw_buffer_load_b128(rs, (int)voff, soff, 0)); }
constexpr int ATT_CK = 0, ATT_CV = 36864, ATT_RP = 70656, ATT_WK = 74496, ATT_WV = 92928, ATT_END = 111360;
template <bool WINDOW>
__device__ __forceinline__ void att_step(const bf16x8 (&kf)[4], const bf16x8 (&vf)[4], const bf16x8 (&qf)[2], f32x4 (&o)[4], float& mrun, float& lrun, LAS const float* rp, const float (&mk)[2][4]) {
    f32x4 t0 = MFMA16(kf[0], qf[0], ((f32x4){0.f, 0.f, 0.f, 0.f})); t0 = MFMA16(kf[1], qf[1], t0);
    f32x4 t1 = MFMA16(kf[2], qf[0], ((f32x4){0.f, 0.f, 0.f, 0.f})); t1 = MFMA16(kf[3], qf[1], t1);
    if (WINDOW) {
#pragma unroll
        for (int j = 0; j < 4; ++j) { t0[j] = (t0[j] + rp[j]) + mk[0][j]; t1[j] = (t1[j] + rp[4 + j]) + mk[1][j]; }
    }
    float cm = fmaxf(fmaxf(fmaxf(t0[0], t0[1]), fmaxf(t0[2], t0[3])), fmaxf(fmaxf(t1[0], t1[1]), fmaxf(t1[2], t1[3])));
    cm = quad_max(cm);
    const float mnew = fmaxf(mrun, cm), alpha = fast_exp2(mrun - mnew);
    float ls = 0.f;
#pragma unroll
    for (int j = 0; j < 4; ++j) { t0[j] = fast_exp2(t0[j] - mnew); t1[j] = fast_exp2(t1[j] - mnew); ls += t0[j] + t1[j]; }
    lrun = lrun * alpha + ls; mrun = mnew;
    u32x4 pw; pw.x = pk2(t0[0], t0[1]); pw.y = pk2(t0[2], t0[3]); pw.z = pk2(t1[0], t1[1]); pw.w = pk2(t1[2], t1[3]);
    const bf16x8 pf = __builtin_bit_cast(bf16x8, pw);
#pragma unroll
    for (int dt = 0; dt < 4; ++dt) { o[dt] = o[dt] * alpha; o[dt] = MFMA16(vf[dt], pf, o[dt]); }
}
template <int NU>
__device__ __forceinline__ void att_ctx(LAS const unsigned char* lds, const bf16x8 (&qf)[4][2], f32x4 (&o)[4][4], float (&mrun)[4], float (&lrun)[4], const float (&mk)[2][4], int n, int q) {
    const unsigned kl = (unsigned)((8 * (n >> 2) + (n & 3)) * 144 + 16 * q), vl = (unsigned)(n * 528 + 16 * q);
#pragma unroll 1
    for (int st = 0; st < 8; ++st) {
        bf16x8 kf[4], vf[4];
        LAS const unsigned char* kp = lds + ATT_CK + st * (32 * 144) + kl; LAS const unsigned char* vp = lds + ATT_CV + st * 64 + vl;
        kf[0] = *(const LAS bf16x8*)kp; kf[1] = *(const LAS bf16x8*)(kp + 64); kf[2] = *(const LAS bf16x8*)(kp + 4 * 144); kf[3] = *(const LAS bf16x8*)(kp + 4 * 144 + 64);
#pragma unroll
        for (int dt = 0; dt < 4; ++dt) vf[dt] = *(const LAS bf16x8*)(vp + dt * (16 * 528));
#pragma unroll
        for (int u = 0; u < NU; ++u) att_step<false>(kf, vf, qf[u], o[u], mrun[u], lrun[u], (LAS const float*)lds, mk);
    }
}
template <bool DUMMY = false>
__device__ __forceinline__ void attn_phase(LAS unsigned char* lds, bf16* Z, const bf16* VT, const float* rpb_g  , bool do_ctx_queries, int vcu, int tid, bf16* dummy = nullptr) {
    const int lane = tid & 63, wave = RFL(tid >> 6), n = lane & 15, q = lane >> 4;
    const int bh = vcu >> 3, jj = vcu & 7, b = bh >> 3, h = bh & 7;
    const rsrc_t rsZ = __builtin_amdgcn_make_buffer_rsrc((void*)Z, (short)0, (int)((size_t)MT * ZP * 2), 0x00020000);
    const rsrc_t rsV = __builtin_amdgcn_make_buffer_rsrc((void*)VT, (short)0, (int)((size_t)BATCH * 8 * 64 * VT_LD * 2), 0x00020000);
#pragma unroll
    for (int i = 0; i < 4; ++i) { const int id = tid + 512 * i;
        { const int key = id >> 3, p = id & 7; *(LAS bf16x8*)(lds + ATT_CK + key * 144 + p * 16) = bld128(rsZ, (unsigned)((key * ZP + 8 * p) * 2), ((ML + b * CTXL) * ZP + K_OFF + h * 64) * 2); }
        { const int d = id >> 5, p = id & 31; *(LAS bf16x8*)(lds + ATT_CV + d * 528 + p * 16) = bld128(rsV, (unsigned)((d * VT_LD + 8 * p) * 2), (bh * 64 * VT_LD + SEQ) * 2); } }
    for (int i = tid; i < 15 * 64; i += 512) { const int dc = (i & 63) - 16; ((LAS float*)(lds + ATT_RP))[i] = (dc >= 0 && dc <= 30) ? rpb_g[(h * 15 + (i >> 6)) * 31 + dc] * 1.44269504088896f : 0.f; }
    __syncthreads();
    const int a = (wave & 3) * 16, par = wave >> 2, s0 = min(max(a - 8, 0), 32), qc = a + n, cs = min(max(qc - 8, 0), 48);
    float mk[2][4];
#pragma unroll
    for (int hf = 0; hf < 2; ++hf)
#pragma unroll
        for (int j = 0; j < 4; ++j) { const int kc = s0 + 8 * q + 4 * hf + j; mk[hf][j] = ((kc >= cs) && (kc < cs + 16)) ? 0.f : -INFINITY; }
    const unsigned qlane = (unsigned)(n * ZP + 8 * q) * 2u, olane = (unsigned)(n * ZP + 4 * q) * 2u;
    const unsigned wkl = (unsigned)((s0 + 8 * (n >> 2) + (n & 3)) * 144 + 16 * q), wvl = (unsigned)(n * 144 + (s0 + 8 * q) * 2);
    LAS const float* rpl = (LAS const float*)(lds + ATT_RP) + (s0 + 8 * q - qc + 31);
    const unsigned stg_k = (unsigned)(((tid >> 3) * ZP + 8 * (tid & 7)) * 2), stg_v = (unsigned)(((tid >> 3) * VT_LD + 8 * (tid & 7)) * 2);
    const unsigned stg_l = (unsigned)((tid >> 3) * 144 + (tid & 7) * 16);
#pragma unroll 1
    for (int pass = 0; pass < 2; ++pass) {
        const int r_first = 16 * jj + 8 * pass, KR0 = min(max(r_first - 4, 0), 120), nrows = min(max(r_first + 7 - 4, 0), 120) + 8 - KR0;
        bf16x8 qf[4][2]; f32x4 o[4][4]; float mrun[4], lrun[4]; int rbu[4];
#pragma unroll
        for (int u = 0; u < 4; ++u) { const int r = r_first + par + 2 * u; rbu[u] = min(max(r - 4, 0), 120);
            const int qso = ((b * SEQ + r * 64 + a) * ZP + Q_OFF + h * 64) * 2;
            qf[u][0] = bld128(rsZ, qlane, qso); qf[u][1] = bld128(rsZ, qlane, qso + 64); mrun[u] = -INFINITY; lrun[u] = 0.f;
#pragma unroll
            for (int dt = 0; dt < 4; ++dt) o[u][dt] = (f32x4){0.f, 0.f, 0.f, 0.f}; }
        const int kg0 = ((b * SEQ + KR0 * 64) * ZP + K_OFF + h * 64) * 2, vg0 = (bh * 64 * VT_LD + KR0 * 64) * 2;
        bf16x8 ka, va, kb_, vb_;
        ka = bld128(rsZ, stg_k, kg0); va = bld128(rsV, stg_v, vg0);
        kb_ = bld128(rsZ, stg_k, kg0 + 64 * ZP * 2); vb_ = bld128(rsV, stg_v, vg0 + 64 * 2);
        *(LAS bf16x8*)(lds + ATT_WK + stg_l) = ka; *(LAS bf16x8*)(lds + ATT_WV + stg_l) = va;
        __syncthreads();
#define ATT_ROW(kk_, slot_, RK, RV, NK, NV) do { const int kk = (kk_); \
            if (kk + 2 < nrows) { NK = bld128(rsZ, stg_k, kg0 + (kk + 2) * (64 * ZP * 2)); NV = bld128(rsV, stg_v, vg0 + (kk + 2) * (64 * 2)); } \
            { bf16x8 kf[4], vf[4]; LAS const unsigned char* kp = lds + ATT_WK + (slot_) * 9216 + wkl; LAS const unsigned char* vp = lds + ATT_WV + (slot_) * 9216 + wvl; \
              kf[0] = *(const LAS bf16x8*)kp; kf[1] = *(const LAS bf16x8*)(kp + 64); kf[2] = *(const LAS bf16x8*)(kp + 4 * 144); kf[3] = *(const LAS bf16x8*)(kp + 4 * 144 + 64); \
              _Pragma("unroll") for (int dt = 0; dt < 4; ++dt) vf[dt] = *(const LAS bf16x8*)(vp + dt * (16 * 144)); \
              _Pragma("unroll") for (int u = 0; u < 4; ++u) { const int krow = KR0 + kk; \
                  if (krow >= rbu[u] && krow < rbu[u] + 8) att_step<true>(kf, vf, qf[u], o[u], mrun[u], lrun[u], rpl + 64 * (krow - (r_first + par + 2 * u) + 7), mk); } } \
            if (kk + 1 < nrows) { *(LAS bf16x8*)(lds + ATT_WK + (1 - (slot_)) * 9216 + stg_l) = RK; *(LAS bf16x8*)(lds + ATT_WV + (1 - (slot_)) * 9216 + stg_l) = RV; } \
            __syncthreads(); } while (0)
#pragma unroll 1
        for (int k2 = 0; k2 < nrows; k2 += 2) {
            ATT_ROW(k2, 0, kb_, vb_, ka, va);
            if (k2 + 1 < nrows) ATT_ROW(k2 + 1, 1, ka, va, kb_, vb_);
        }
#undef ATT_ROW
        att_ctx<4>(lds, qf, o, mrun, lrun, mk, n, q);
#pragma unroll
        for (int u = 0; u < 4; ++u) { float lt = lrun[u]; lt = quad_sum(lt); const float inv = 1.0f / lt;
            const int qso = ((b * SEQ + (r_first + par + 2 * u) * 64 + a) * ZP + Q_OFF + h * 64) * 2;
#pragma unroll
            for (int dt = 0; dt < 4; ++dt) { u32x2 w; w.x = pk2(o[u][dt][0] * inv, o[u][dt][1] * inv); w.y = pk2(o[u][dt][2] * inv, o[u][dt][3] * inv);
                if (DUMMY) *(u32x2*)(dummy + ((size_t)(vcu * 8 + wave) * 16 + n) * 64 + 16 * dt + 4 * q) = w; else __builtin_amdgcn_raw_buffer_store_b64(w, rsZ, (int)olane, qso + 32 * dt, 0); } }
    }
    if (do_ctx_queries && wave < 2) {
        bf16x8 qf[4][2]; f32x4 o[4][4]; float mrun[4], lrun[4];
        const int qso = ((ML + b * CTXL + 16 * (2 * jj + wave)) * ZP + Q_OFF + h * 64) * 2;
        qf[0][0] = bld128(rsZ, qlane, qso); qf[0][1] = bld128(rsZ, qlane, qso + 64); mrun[0] = -INFINITY; lrun[0] = 0.f;
#pragma unroll
        for (int dt = 0; dt < 4; ++dt) o[0][dt] = (f32x4){0.f, 0.f, 0.f, 0.f};
        att_ctx<1>(lds, qf, o, mrun, lrun, mk, n, q);
        float lt = lrun[0]; lt = quad_sum(lt); const float inv = 1.0f / lt;
#pragma unroll
        for (int dt = 0; dt < 4; ++dt) { u32x2 w; w.x = pk2(o[0][dt][0] * inv, o[0][dt][1] * inv); w.y = pk2(o[0][dt][2] * inv, o[0][dt][3] * inv);
            if (DUMMY) *(u32x2*)(dummy + ((size_t)(vcu * 8 + wave) * 16 + n) * 64 + 16 * dt + 4 * q) = w; else __builtin_amdgcn_raw_buffer_store_b64(w, rsZ, (int)olane, qso + 32 * dt, 0); }
    }
}

__device__ __forceinline__ void f1_unit(const bf16* Z, bf16* R, LAS const unsigned char* T64, LAS const unsigned char* TA, int b_, int g_, int l2_, int cb_, int lane) {
    const int b = RFL(b_), g = RFL(g_), l2 = RFL(l2_), cb = RFL(cb_);
    const int n = lane & 15, q = lane >> 4;
    const char* ubase = (const char*)(Z + (size_t)(b * SEQ + l2) * ZP + g * 64); const unsigned ulane = (unsigned)(n * 64 * ZP + 8 * q) * 2u;
    f32x4 pr[8], pi[8];
#pragma unroll
    for (int mt = 0; mt < 8; ++mt) { pr[mt] = (f32x4){0.f, 0.f, 0.f, 0.f}; pi[mt] = (f32x4){0.f, 0.f, 0.f, 0.f}; }
#pragma unroll
    for (int ks = 0; ks < 2; ++ks) {
        const bf16x8 bre = *(const LAS bf16x8*)(T64 + ((0 * 64 + 16 * cb + n) * 64 + 32 * ks + 8 * q) * 2);
        const bf16x8 bim = *(const LAS bf16x8*)(T64 + ((1 * 64 + 16 * cb + n) * 64 + 32 * ks + 8 * q) * 2);
#pragma unroll
        for (int mt = 0; mt < 8; ++mt) {
            const bf16x8 av = ldg_u<bf16x8>(ubase + ((size_t)(16 * mt * 64) * ZP + 32 * ks) * 2, ulane);
            pr[mt] = MFMA16(av, bre, pr[mt]); pi[mt] = MFMA16(av, bim, pi[mt]); }
        __builtin_amdgcn_sched_barrier(0);
    }
    bf16x8 fr[4], fi[4], fn[4];
#pragma unroll
    for (int k2 = 0; k2 < 4; ++k2) {
        u32x4 wr_, wi_, wn_;
        wr_.x = pk2(pr[2 * k2][0], pr[2 * k2][1]); wr_.y = pk2(pr[2 * k2][2], pr[2 * k2][3]); wr_.z = pk2(pr[2 * k2 + 1][0], pr[2 * k2 + 1][1]); wr_.w = pk2(pr[2 * k2 + 1][2], pr[2 * k2 + 1][3]);
        wi_.x = pk2(pi[2 * k2][0], pi[2 * k2][1]); wi_.y = pk2(pi[2 * k2][2], pi[2 * k2][3]); wi_.z = pk2(pi[2 * k2 + 1][0], pi[2 * k2 + 1][1]); wi_.w = pk2(pi[2 * k2 + 1][2], pi[2 * k2 + 1][3]);
        wn_ = wr_ ^ 0x80008000u;
        fr[k2] = __builtin_bit_cast(bf16x8, wr_); fi[k2] = __builtin_bit_cast(bf16x8, wi_); fn[k2] = __builtin_bit_cast(bf16x8, wn_);
    }
    char* rbase = (char*)(R + (size_t)(b * 4 + g) * 128 * 64 * 128 + (size_t)l2 * 128 + 16 * cb); const unsigned rlane = (unsigned)(4 * q * 64 * 128 + n) * 2u;
#pragma unroll
    for (int mt = 0; mt < 8; ++mt) {
        f32x4 qr = (f32x4){0.f, 0.f, 0.f, 0.f}, qi = (f32x4){0.f, 0.f, 0.f, 0.f};
#pragma unroll
        for (int k2 = 0; k2 < 4; ++k2) {
            const bf16x8 ac = *(const LAS bf16x8*)(TA + (((0 * 8 + mt) * 4 + k2) * 64 + lane) * 16);
            const bf16x8 as = *(const LAS bf16x8*)(TA + (((1 * 8 + mt) * 4 + k2) * 64 + lane) * 16);
            qr = MFMA16(ac, fr[k2], qr); qr = MFMA16(as, fi[k2], qr); qi = MFMA16(ac, fi[k2], qi); qi = MFMA16(as, fn[k2], qi);
        }
#pragma unroll
        for (int j = 0; j < 4; ++j) { const int k1 = 16 * mt + 4 * q + j; const float ang = (float)((l2 * k1) & 8191) * (1.0f / 4096.0f);
            const float ct = cospif(ang), st = sinpif(ang);
            const float rr = qr[j] * ct + qi[j] * st, ri = qi[j] * ct - qr[j] * st;
            char* p = rbase + (size_t)((16 * mt + j) * 64 * 128) * 2;
            *(bf16*)(p + rlane) = (bf16)(pk2(rr, 0.f) & 0xffffu); *(bf16*)(p + 128 + rlane) = (bf16)(pk2(ri, 0.f) & 0xffffu); }
        __builtin_amdgcn_sched_barrier(0);
    }
}
__device__ __forceinline__ void f3_unit(const bf16* R, bf16* Z, LAS const unsigned char* T3F, LAS unsigned char* scr, int b, int g, int k1, int ch, int lane) {
    const int n = lane & 15, q = lane >> 4;
    const bf16* Rb = R + ((size_t)((b * 4 + g) * 128 + k1) * 64) * 128;
#pragma unroll
    for (int i = 0; i < 8; ++i) { const int p = lane + 64 * i, l2 = p >> 3, reim = (p >> 2) & 1, piece = p & 3;
        const u32x4 v = *(const u32x4*)(Rb + (l2 * 2 + reim) * 64 + 32 * ch + 8 * piece);
        *(LAS u32x4*)(scr + l2 * 144 + reim * 64 + piece * 16) = v; }
    LDS_WAIT(); asm volatile("" ::: "memory");
    bf16x8 bfr[2][4];
#pragma unroll
    for (int nt = 0; nt < 2; ++nt)
#pragma unroll
        for (int ks = 0; ks < 4; ++ks) { u32x4 w; unsigned e[8];
#pragma unroll
            for (int j = 0; j < 8; ++j) { const int l2 = 32 * (ks & 1) + 8 * q + j; e[j] = *(const LAS unsigned short*)(scr + l2 * 144 + (ks >> 1) * 64 + (16 * nt + n) * 2); }
            w.x = e[0] | (e[1] << 16); w.y = e[2] | (e[3] << 16); w.z = e[4] | (e[5] << 16); w.w = e[6] | (e[7] << 16);
            bfr[nt][ks] = __builtin_bit_cast(bf16x8, w); }
    const float sc = 0.00138106793f;
#pragma unroll
    for (int mt = 0; mt < 4; ++mt) {
        f32x4 y0 = (f32x4){0.f, 0.f, 0.f, 0.f}, y1 = (f32x4){0.f, 0.f, 0.f, 0.f};
#pragma unroll
        for (int ks = 0; ks < 4; ++ks) { const bf16x8 av = *(const LAS bf16x8*)(T3F + ((mt * 4 + ks) * 64 + lane) * 16);
            y0 = MFMA16(av, bfr[0][ks], y0); y1 = MFMA16(av, bfr[1][ks], y1); }
#pragma unroll
        for (int j = 0; j < 4; ++j) { const int k2 = 16 * mt + 4 * q + j; bf16* p = Z + (size_t)(b * SEQ + k1 + 128 * k2) * ZP + g * 64 + 32 * ch + n;
            p[0] = (bf16)(pk2(y0[j] * sc, 0.f) & 0xffffu); p[16] = (bf16)(pk2(y1[j] * sc, 0.f) & 0xffffu); }
    }
    LDS_WAIT(); asm volatile("" ::: "memory");
}

__device__ __forceinline__ void stagger(unsigned ticks) {
    const unsigned dl = ((blockIdx.x >> 3) & 7u) * ticks; const unsigned long long t0 = __builtin_amdgcn_s_memrealtime();
    while ((unsigned)(__builtin_amdgcn_s_memrealtime() - t0) < dl) __builtin_amdgcn_s_sleep(4);
}
#ifndef STAG_INPROJ
#define STAG_INPROJ 0
#endif
struct Args { const float* in[23]; float* out; unsigned char* ws; };
__device__ __forceinline__ unsigned long long pt_get(LAS const unsigned long long* PT, int i) {
    int off = i; asm volatile("" : "+v"(off));
    const unsigned long long v = PT[off];
    const unsigned lo = __builtin_amdgcn_readfirstlane((unsigned)v), hi = __builtin_amdgcn_readfirstlane((unsigned)(v >> 32));
    return ((unsigned long long)hi << 32) | lo;
}
#define INP(i) ((const float*)(const GAS float*)pt_get(PT, (i)))
#define OUTP ((float*)(GAS float*)pt_get(PT, 23))
#define WSP(off) ((unsigned char*)(GAS unsigned char*)(pt_get(PT, 24) + (unsigned long long)(off)))

#define PHASE_IDS() const int tid = fresh_tid(), lane = tid & 63, wave = __builtin_amdgcn_readfirstlane(tid >> 6); const int G = fresh_s((int)gridDim.x), bx = fresh_s((int)blockIdx.x); \
    const int vcu = (G % 8 == 0) ? (bx % 8) * (G / 8) + bx / 8 : bx; const int gw = vcu * NWAVES + wave, NGW = G * NWAVES; (void)tid; (void)lane; (void)wave; (void)vcu; (void)gw; (void)NGW; (void)bx
__global__ void __launch_bounds__(NWAVES * 64, 2) fwd_kernel(Args args) {
    extern __shared__ __attribute__((aligned(16))) unsigned char lds_raw[];
    LAS unsigned char* lds = (LAS unsigned char*)lds_raw;
    volatile LAS unsigned* MISC = (volatile LAS unsigned*)(lds + MISC_OFF);
    LAS unsigned long long* PT = (LAS unsigned long long*)(lds + LDSCTL_OFF + 512);
    { const int tid = threadIdx.x;

    for (int u = tid; u < (LDS_BYTES - LDSCTL_OFF) / 4; u += NWAVES * 64) ((LAS unsigned*)(lds + LDSCTL_OFF))[u] = 0u;
    __syncthreads();
    if (tid < 23) PT[tid] = (unsigned long long)args.in[tid];
    if (tid == 23) PT[23] = (unsigned long long)args.out;
    if (tid == 24) PT[24] = (unsigned long long)args.ws;
    __syncthreads();
    }
    XcdBarrier bar = xcd_barrier_post((unsigned*)WSP(WS_CTL) + CW_BAR, MISC + 8);
#define GRID_BAR() xcd_barrier(bar)
#ifdef PROBE_GA
    LAS unsigned* TSW = (LAS unsigned*)(lds + LDSCTL_OFF + 2048);
    if (blockIdx.x == 0 && threadIdx.x == 0) TSW[32] = (unsigned)wall_clock64();
#define STAMP(g) do { if (blockIdx.x == 0 && threadIdx.x == 0) { const unsigned t_ = (unsigned)wall_clock64(); TSW[(g)] += t_ - TSW[32]; TSW[32] = t_; } } while (0)
#else
#define STAMP(g) do { } while (0)
#endif

    {
            PHASE_IDS();
        if (vcu < 192) {
            LAS float* S = (LAS float*)lds;
            LAS float* P = (LAS float*)(lds + 32768);
            { const float* c_in = INP(1); const float* cctx_in = INP(3);
              for (int i = tid; i < 5 * D; i += NWAVES * 64) { const int v = i >> 10, k = i & 1023; const float cv = v < 4 ? c_in[v * D + k] : cctx_in[k]; S[i] = cv / (1.0f + __expf(-cv)); } }
            __syncthreads();
            const int l = vcu / 96, j = (vcu % 96) * 64 + lane;
            const float* W = INP(6) + (size_t)l * D * NMOD + j;
            float a0 = 0.f, a1 = 0.f, a2 = 0.f, a3 = 0.f, a4 = 0.f;
#pragma unroll 32
            for (int kk = 0; kk < 128; ++kk) { const int k = wave * 128 + kk; const float w = W[(size_t)k * NMOD];
                a0 += S[k] * w; a1 += S[D + k] * w; a2 += S[2 * D + k] * w; a3 += S[3 * D + k] * w; a4 += S[4 * D + k] * w; }
            P[(wave * 5 + 0) * 64 + lane] = a0; P[(wave * 5 + 1) * 64 + lane] = a1; P[(wave * 5 + 2) * 64 + lane] = a2; P[(wave * 5 + 3) * 64 + lane] = a3; P[(wave * 5 + 4) * 64 + lane] = a4;
            __syncthreads();
            if (wave < 5) { float s = INP(7)[l * NMOD + j];
#pragma unroll
                for (int w8 = 0; w8 < 8; ++w8) s += P[(w8 * 5 + wave) * 64 + lane];
                ((float*)WSP(WS_MOD))[((size_t)l * 5 + wave) * NMOD + j] = s; }
        }
        { bf16* TB = (bf16*)WSP(WS_TAB);
          for (int i = vcu * 512 + tid; i < 49152; i += G * 512) { float v;
              if (i < 8192) { const int reim = i >> 12, cp = (i >> 6) & 63, c = i & 63; const float ang = (float)((c * cp) & 63) * (1.0f / 32.0f); v = reim ? -sinpif(ang) : cospif(ang); }
              else if (i < 40960) { const int ii = i - 8192, e = ii & 7, ln = (ii >> 3) & 63, k2 = (ii >> 9) & 3, mt = (ii >> 11) & 7, cs = ii >> 14;
                  const int k1 = 16 * mt + (ln & 15), qq = ln >> 4, l1 = 32 * k2 + (e < 4 ? 4 * qq + e : 16 + 4 * qq + (e - 4));
                  const float ang = (float)((k1 * l1) & 127) * (1.0f / 64.0f); v = cs ? sinpif(ang) : cospif(ang); }
              else { const int ii = i - 40960, e = ii & 7, ln = (ii >> 3) & 63, ks = (ii >> 9) & 3, mt = ii >> 11;
                  const int k2 = 16 * mt + (ln & 15), kap = 32 * ks + 8 * (ln >> 4) + e, l2 = kap & 63;
                  const float ang = (float)((k2 * l2) & 63) * (1.0f / 32.0f); v = (kap >= 64) ? sinpif(ang) : cospif(ang); }
              TB[i] = (bf16)(pk2(v, 0.f) & 0xffffu); } }
        __syncthreads();
        LAS float* scr = (LAS float*)(lds + wave * 16384);
        int base = 0;
#pragma unroll 1
        for (int l = 0; l < 2; ++l) {
            tr_matrix(INP(8) + (size_t)l * D * PW, D, PW, (bf16*)WSP(WS_WIN) + (size_t)l * PW * D, D, 0, 0, base, gw, NGW, scr, lane);
            tr_matrix(INP(11) + (size_t)l * 256 * D, 256, D, (bf16*)WSP(WS_WCAT) + (size_t)l * D * D, D, 0, 0, base, gw, NGW, scr, lane);
            tr_matrix(INP(12) + (size_t)l * 512 * D, 512, D, (bf16*)WSP(WS_WCAT) + (size_t)l * D * D, D, 256, 0, base, gw, NGW, scr, lane);
            tr_matrix(INP(13) + (size_t)l * 256 * D, 256, D, (bf16*)WSP(WS_WCAT) + (size_t)l * D * D, D, 768, 0, base, gw, NGW, scr, lane);
            tr_matrix(INP(14) + (size_t)l * D * D, D, D, (bf16*)WSP(WS_WOUT) + (size_t)l * D * D, D, 0, 0, base, gw, NGW, scr, lane);
        }
        tr_matrix(INP(15), D, DFF, (bf16*)WSP(WS_WGU0), D, 0, 1, base, gw, NGW, scr, lane);
        tr_matrix(INP(16), D, DFF, (bf16*)WSP(WS_WGU0), D, 0, 2, base, gw, NGW, scr, lane);
        tr_matrix(INP(17), DFF, D, (bf16*)WSP(WS_WD0), DFF, 0, 0, base, gw, NGW, scr, lane);
    }
    GRID_BAR(); STAMP(0);

#pragma unroll 1
    for (int l = 0; l < 2; ++l) {
        const int Mmix = (l == 0) ? MT : ML;

        {
            PHASE_IDS();
            LAS float* TA_ = (LAS float*)lds; LAS float* TS_ = (LAS float*)(lds + 20480);
            norm_tables(TA_, TS_, INP(4) + l * D, (const float*)WSP(WS_MOD) + (size_t)l * 5 * NMOD, 0, D, tid);
            __syncthreads();
            bf16* HX = (bf16*)WSP(WS_HX);
            const float* xl_cur = (l == 0) ? INP(0) : (const float*)OUTP; const float* xc_cur = (l == 0) ? INP(2) : (const float*)WSP(WS_XC);
            norm_phase_rows(xl_cur, xc_cur, ML, TA_, TS_, HX, gw, NGW, lane);
            if (l == 0) norm_ctx_rows<0, 0>(INP(2), nullptr, nullptr, TA_, TS_, HX, gw, NGW, lane);
            else norm_ctx_rows<4, 11>(INP(2), (const float*)WSP(WS_R), (const float*)WSP(WS_PART), TA_, TS_, HX, gw, NGW, lane);
        }
        GRID_BAR(); STAMP(1);

        { pg8::Gemm g{D, D}; pg8::SchedPlain S; S.init(MT, PW, D, (const bf16*)WSP(WS_HX), D, (const bf16*)WSP(WS_WIN) + (size_t)l * PW * D, D, fresh_s((int)gridDim.x), fresh_s((int)blockIdx.x));
          pg8::EpiInProj E{(bf16*)WSP(WS_Z), (bf16*)WSP(WS_VT), (unsigned char*)WSP(WS_GQ)};
          if (STAG_INPROJ) stagger(STAG_INPROJ);
          pg8::gemm_phase<pg8::EpiInProj, pg8::SchedPlain>(lds, g, S, E);
#ifdef DUP_INPROJ
          GRID_BAR(); pg8::gemm_phase<pg8::EpiInProj, pg8::SchedPlain>(lds, g, S, E);
#endif
        }
        GRID_BAR(); STAMP(2);

        {
            PHASE_IDS();
            LAS unsigned char* T64 = lds;
            LAS unsigned char* TA = lds + 16384;
            LAS float* C64 = (LAS float*)(lds + 120832);
            LAS float* CW = (LAS float*)(lds + 120832 + 512);
            { const u32x4* TB = (const u32x4*)WSP(WS_TAB);
#pragma unroll
              for (int i = 0; i < 10; ++i) *(LAS u32x4*)(lds + (tid + 512 * i) * 16) = TB[tid + 512 * i]; }
            if (tid < 64) { const float ang = (float)tid * (1.0f / 32.0f); C64[tid] = cospif(ang); C64[64 + tid] = sinpif(ang); }
            { const float* cw = INP(9) + l * 768; for (int i = tid; i < 768; i += NWAVES * 64) CW[i] = cw[i]; }
            __syncthreads();
            bf16* Z = (bf16*)WSP(WS_Z);
#ifndef SKIP_F1
#ifdef DUP_F
            { bf16* RB = (bf16*)WSP(WS_R);
              _Pragma("unroll 1") for (int uid = gw; uid < 4096; uid += NGW) f1_unit(Z, RB, T64, TA, uid >> 10, (uid >> 8) & 3, (uid >> 2) & 63, uid & 3, lane); }
#endif
            { bf16* RB = (bf16*)WSP(WS_R);
              _Pragma("unroll 1") for (int uid = gw; uid < 4096; uid += NGW) f1_unit(Z, RB, T64, TA, uid >> 10, (uid >> 8) & 3, (uid >> 2) & 63, uid & 3, lane); }
#endif
            if (l == 0) { unsigned* CP = (unsigned*)WSP(WS_CP);
              for (int it = vcu * 512 + tid; it < MC * 256; it += G * 512) { const int cp = it & 63, gg = (it >> 6) & 3, tok = it >> 8;
                const bf16* up = Z + (size_t)(ML + tok) * ZP + gg * 64; float pr = 0.f, pi = 0.f;
#pragma unroll
                for (int c8 = 0; c8 < 8; ++c8) { const u32x4 w = *(const u32x4*)(up + 8 * c8); const float uv[8] = {bflo(w.x), bfhi(w.x), bflo(w.y), bfhi(w.y), bflo(w.z), bfhi(w.z), bflo(w.w), bfhi(w.w)};
#pragma unroll
                    for (int j = 0; j < 8; ++j) { const int idx = ((8 * c8 + j) * cp) & 63; pr += uv[j] * C64[idx]; pi -= uv[j] * C64[64 + idx]; } }
                CP[(((size_t)((tok >> 8) * 4 + gg) * 256 + (tok & 255)) * 64 + cp)] = pk2(pr, pi); } }
            for (int it = vcu * 512 + tid; it < Mmix * 32; it += G * 512) { const int row = it >> 5, ch = (it & 31) * 8;
                const bool lat = row < ML; const int pos = lat ? (row & 8191) : ((row - ML) & 255), len = lat ? SEQ : CTXL;
                bf16* zr = Z + (size_t)row * ZP; float p[3][8];
#pragma unroll
                for (int d = 0; d < 3; ++d) { const bool ok = (d == 1) || (d == 0 ? pos > 0 : pos < len - 1);
                    if (ok) { const bf16* rr = zr + (ptrdiff_t)(d - 1) * ZP; const u32x4 wu = *(const u32x4*)(rr + U_OFF + ch), wc = *(const u32x4*)(rr + C_OFF + ch);
                        p[d][0] = bflo(wu.x) * bflo(wc.x); p[d][1] = bfhi(wu.x) * bfhi(wc.x); p[d][2] = bflo(wu.y) * bflo(wc.y); p[d][3] = bfhi(wu.y) * bfhi(wc.y);
                        p[d][4] = bflo(wu.z) * bflo(wc.z); p[d][5] = bfhi(wu.z) * bfhi(wc.z); p[d][6] = bflo(wu.w) * bflo(wc.w); p[d][7] = bfhi(wu.w) * bfhi(wc.w); }
                    else {
#pragma unroll
                        for (int j = 0; j < 8; ++j) p[d][j] = 0.f; } }
                const u32x4 wb = *(const u32x4*)(zr + B_OFF + ch); const float zb[8] = {bflo(wb.x), bfhi(wb.x), bflo(wb.y), bfhi(wb.y), bflo(wb.z), bfhi(wb.z), bflo(wb.w), bfhi(wb.w)};
                float o[8];
#pragma unroll
                for (int j = 0; j < 8; ++j) o[j] = zb[j] * (CW[ch + j] * p[0][j] + CW[256 + ch + j] * p[1][j] + CW[512 + ch + j] * p[2][j]);
                u32x4 w; w.x = pk2(o[0], o[1]); w.y = pk2(o[2], o[3]); w.z = pk2(o[4], o[5]); w.w = pk2(o[6], o[7]);
                *(u32x4*)(zr + B_OFF + ch) = w; }
        }
        GRID_BAR(); STAMP(3);

        {
            PHASE_IDS();
            LAS unsigned char* T3F = lds;
            LAS float* C256 = (LAS float*)(lds + 16384);
            LAS unsigned char* scr = lds + 32768 + wave * 9216;
            { const u32x4* TB = (const u32x4*)(WSP(WS_TAB) + 81920);
#pragma unroll
              for (int i = 0; i < 2; ++i) *(LAS u32x4*)(lds + (tid + 512 * i) * 16) = TB[tid + 512 * i]; }
            if (tid < 256) { const float ang = (float)tid * (1.0f / 128.0f); C256[tid] = cospif(ang); C256[256 + tid] = sinpif(ang); }
            __syncthreads();
            bf16* Z = (bf16*)WSP(WS_Z);
#ifndef SKIP_F3
#ifdef DUP_F
            { const bf16* RB = (const bf16*)WSP(WS_R);
              _Pragma("unroll 1") for (int uid = gw; uid < 4096; uid += NGW) f3_unit(RB, Z, T3F, scr, uid >> 10, (uid >> 8) & 3, (uid >> 1) & 127, uid & 1, lane); }
#endif
            { const bf16* RB = (const bf16*)WSP(WS_R);
              _Pragma("unroll 1") for (int uid = gw; uid < 4096; uid += NGW) f3_unit(RB, Z, T3F, scr, uid >> 10, (uid >> 8) & 3, (uid >> 1) & 127, uid & 1, lane); }
#endif
            if (l == 0) { __syncthreads();
                LAS unsigned* PS = (LAS unsigned*)(lds + 32768);
                const int b = vcu >> 6, gg = (vcu >> 4) & 3, lp0 = (vcu & 15) * 16;
                const unsigned* CPs = (const unsigned*)WSP(WS_CP) + (size_t)(b * 4 + gg) * 256 * 64;
#pragma unroll
                for (int i = 0; i < 8; ++i) *(LAS u32x4*)(PS + (tid + 512 * i) * 4) = *(const u32x4*)(CPs + (tid + 512 * i) * 4);
                __syncthreads();
                const int cp = tid & 63, lpa = lp0 + (tid >> 6), lpb = lpa + 8; float ya = 0.f, yb = 0.f;
#pragma unroll 8
                for (int li = 0; li < CTXL; ++li) { const unsigned w = PS[li * 64 + cp]; const float pr = bflo(w), pi = bfhi(w); const int ia = (li * lpa) & 255, ib = (li * lpb) & 255;
                    ya += C256[ia] * pr + C256[256 + ia] * pi; yb += C256[ib] * pr + C256[256 + ib] * pi; }
                Z[(size_t)(ML + b * CTXL + lpa) * ZP + gg * 64 + cp] = (bf16)(pk2(ya * (1.0f / 128.0f), 0.f) & 0xffffu);
                Z[(size_t)(ML + b * CTXL + lpb) * ZP + gg * 64 + cp] = (bf16)(pk2(yb * (1.0f / 128.0f), 0.f) & 0xffffu); }
            __syncthreads();
#ifdef DUP_ATTN
            attn_phase<true>(lds, Z, (const bf16*)WSP(WS_VT), INP(10) + (size_t)l * 8 * 465, l == 0, vcu, tid, (bf16*)WSP(WS_HX)); __syncthreads();
#endif
#ifndef SKIP_ATTN
            attn_phase(lds, Z, (const bf16*)WSP(WS_VT), INP(10) + (size_t)l * 8 * 465, l == 0, vcu, tid);
#endif
        }
        GRID_BAR(); STAMP(4);

        { pg8::Gemm g{ZP, D}; pg8::SchedMerge S{Mmix / 256, fresh_s((int)gridDim.x), fresh_s((int)blockIdx.x), (const char*)WSP(WS_Z), (const char*)((const bf16*)WSP(WS_WCAT) + (size_t)l * D * D)};
          pg8::EpiMerge E{(const unsigned char*)WSP(WS_GQ), (bf16*)WSP(WS_HX)};
          pg8::gemm_phase<pg8::EpiMerge, pg8::SchedMerge>(lds, g, S, E);
#ifdef DUP_MERGE
          GRID_BAR(); pg8::gemm_phase<pg8::EpiMerge, pg8::SchedMerge>(lds, g, S, E);
#endif
        }
        GRID_BAR(); STAMP(5);

        { pg8::Gemm g{D, D}; pg8::SchedSplitCtx S{fresh_s((int)gridDim.x), fresh_s((int)blockIdx.x), D / 64, l == 0 ? 1 : 0, (const char*)WSP(WS_HX), (const char*)((const bf16*)WSP(WS_WOUT) + (size_t)l * D * D), (size_t)256 * D * 2, (size_t)256 * D * 2};
          pg8::EpiResid E{(l == 0) ? INP(0) : (const float*)OUTP, nullptr, OUTP, nullptr, (const float*)WSP(WS_MOD) + (size_t)l * 5 * NMOD + 2 * D, (float*)WSP(WS_R)};
          pg8::gemm_phase<pg8::EpiResid, pg8::SchedSplitCtx>(lds, g, S, E);
#ifdef DUP_OUTPROJ
          if (l == 0) { GRID_BAR(); pg8::gemm_phase<pg8::EpiResid, pg8::SchedPlain>(lds, g, S, E); }
#endif
        }
        GRID_BAR(); STAMP(6);

        if (l == 0) {
            {
            PHASE_IDS();
                LAS float* TA_ = (LAS float*)lds; LAS float* TS_ = (LAS float*)(lds + 20480);
                norm_tables(TA_, TS_, INP(5), (const float*)WSP(WS_MOD), 3 * D, 4 * D, tid);
                __syncthreads();
                bf16* HX = (bf16*)WSP(WS_HX); const float* xl = OUTP; const float* xc = (const float*)WSP(WS_XC);
                norm_phase_rows(xl, xc, ML, TA_, TS_, HX, gw, NGW, lane);
                norm_ctx_rows<4, 0>(INP(2), (const float*)WSP(WS_R), nullptr, TA_, TS_, HX, gw, NGW, lane);
            }
            GRID_BAR(); STAMP(1);
            { pg8::Gemm g{D, D}; pg8::SchedPlain S; S.init(MT, 2 * DFF, D, (const bf16*)WSP(WS_HX), D, (const bf16*)WSP(WS_WGU0), D, fresh_s((int)gridDim.x), fresh_s((int)blockIdx.x));
              pg8::EpiSwiglu E{(bf16*)WSP(WS_G), DFF};
#ifdef DUP_FFNUP_REP
              { pg8::SchedPlainRep SR; SR.init(MT, 2 * DFF, D, (const bf16*)WSP(WS_HX), D, (const bf16*)WSP(WS_WGU0), D, fresh_s((int)gridDim.x), fresh_s((int)blockIdx.x)); SR.rep = DUP_FFNUP_REP;
                pg8::EpiNull E0{(float*)WSP(WS_R)}; pg8::gemm_phase<pg8::EpiNull, pg8::SchedPlainRep>(lds, g, SR, E0); GRID_BAR(); }
#endif
              pg8::gemm_phase<pg8::EpiSwiglu, pg8::SchedPlain>(lds, g, S, E);
#ifdef DUP_FFNUP
              GRID_BAR(); pg8::gemm_phase<pg8::EpiSwiglu, pg8::SchedPlain>(lds, g, S, E);
#endif
            }
            GRID_BAR(); STAMP(7);
            { pg8::Gemm g{DFF, DFF}; pg8::SchedSplitCtx S{fresh_s((int)gridDim.x), fresh_s((int)blockIdx.x), DFF / 64, 1, (const char*)WSP(WS_G), (const char*)WSP(WS_WD0), (size_t)256 * DFF * 2, (size_t)256 * DFF * 2};
              pg8::EpiResid E{OUTP, nullptr, OUTP, nullptr, (const float*)WSP(WS_MOD) + 5 * D, (float*)WSP(WS_PART)};
              pg8::gemm_phase<pg8::EpiResid, pg8::SchedSplitCtx>(lds, g, S, E); }
            GRID_BAR(); STAMP(8);
        } else {
            {
            PHASE_IDS();
                LAS float* WR = (LAS float*)lds;
                LAS int* LC = (LAS int*)(lds + 32768);
                LAS unsigned* RT = (LAS unsigned*)(lds + 32768 + 64);
                { const float* wr = INP(18); for (int i = tid; i < D * NE; i += NWAVES * 64) WR[i] = wr[i]; }
                if (tid < 16) LC[tid] = 0;
                __syncthreads();
                const int rpw = ML / (G * NWAVES);
                {
                LAS float* TA_ = (LAS float*)(lds + 40960); LAS float* TS_ = (LAS float*)(lds + 61440);
                norm_tables(TA_, TS_, INP(5) + D, (const float*)WSP(WS_MOD) + (size_t)5 * NMOD, 3 * D, 4 * D, tid);
                __syncthreads();
                bf16* HX = (bf16*)WSP(WS_HX); const float* xl = OUTP;
#pragma unroll 1
                for (int i = 0; i < rpw; i += 2) { const int rl = wave * rpw + i, row = vcu * (rpw * NWAVES) + rl, v = row >> 13;
                    f32x4 hv[2][4]; norm_rows2(xl + (size_t)row * D, xl + (size_t)(row + 1) * D, TA_ + v * D, TS_ + v * D, TA_ + v * D, TS_ + v * D, HX + (size_t)row * D, HX + (size_t)(row + 1) * D, true, lane, hv[0], hv[1]);
                    float lg[2][NE];
#pragma unroll
                    for (int e = 0; e < NE; ++e) { lg[0][e] = 0.f; lg[1][e] = 0.f; }
#pragma unroll
                    for (int j = 0; j < 4; ++j)
#pragma unroll
                        for (int cc = 0; cc < 4; ++cc) { const int k = 4 * lane + 256 * j + cc; const f32x4 w0 = *(const LAS f32x4*)(WR + k * 8), w1 = *(const LAS f32x4*)(WR + k * 8 + 4);
#pragma unroll
                            for (int t = 0; t < 2; ++t) { const float hvv = hv[t][j][cc];
                                lg[t][0] += hvv * w0.x; lg[t][1] += hvv * w0.y; lg[t][2] += hvv * w0.z; lg[t][3] += hvv * w0.w; lg[t][4] += hvv * w1.x; lg[t][5] += hvv * w1.y; lg[t][6] += hvv * w1.z; lg[t][7] += hvv * w1.w; } }
#pragma unroll
                    for (int o = 1; o < 64; o <<= 1)
#pragma unroll
                        for (int e = 0; e < NE; ++e) { lg[0][e] += shx(lg[0][e], o, lane); lg[1][e] += shx(lg[1][e], o, lane); }
#pragma unroll
                    for (int t = 0; t < 2; ++t) {
                        int e0 = 0; float v0 = lg[t][0];
#pragma unroll
                        for (int e = 1; e < NE; ++e) if (lg[t][e] > v0) { v0 = lg[t][e]; e0 = e; }
                        int e1 = -1; float v1 = -INFINITY;
#pragma unroll
                        for (int e = 0; e < NE; ++e) if (e != e0 && lg[t][e] > v1) { v1 = lg[t][e]; e1 = e; }
                        const float w1 = 1.0f / (1.0f + __expf(v0 - v1)), w0 = 1.0f - w1;
                        if (lane == 0) { const int s0 = __hip_atomic_fetch_add(LC + e0, 1, __ATOMIC_RELAXED, __HIP_MEMORY_SCOPE_WORKGROUP), s1 = __hip_atomic_fetch_add(LC + e1, 1, __ATOMIC_RELAXED, __HIP_MEMORY_SCOPE_WORKGROUP);
                            LAS unsigned* rt = RT + (rl + t) * 6; rt[0] = (unsigned)e0; rt[1] = (unsigned)s0; rt[2] = (unsigned)e1; rt[3] = (unsigned)s1; rt[4] = __float_as_uint(w0); rt[5] = __float_as_uint(w1); } }
                }
                }
                __syncthreads();
                if (tid < NE) LC[8 + tid] = (int)xb_add((unsigned*)WSP(WS_CTL) + CW_CNT + 64 * tid, (unsigned)LC[tid]);
                __syncthreads();
                if (tid < rpw * NWAVES) { const int row = vcu * (rpw * NWAVES) + tid; const unsigned e0 = RT[tid * 6], e1 = RT[tid * 6 + 2];
                    u32x4 r; r.x = e0 | ((unsigned)(LC[8 + e0] + (int)RT[tid * 6 + 1]) << 8); r.y = e1 | ((unsigned)(LC[8 + e1] + (int)RT[tid * 6 + 3]) << 8); r.z = RT[tid * 6 + 4]; r.w = RT[tid * 6 + 5];
                    ((u32x4*)WSP(WS_ROUTE))[row] = r; }
                __syncthreads();
                LAS float* scr = (LAS float*)(lds + wave * 16384);
                int base = 0;
#ifdef DUP_MOECONV
#pragma unroll 1
                for (int e = 0; e < NE; ++e) {
                    tr_matrix(INP(19) + (size_t)e * D * DFE, D, DFE, (bf16*)WSP(WS_WMGU) + (size_t)e * 2 * DFE * D, D, 0, 1, base, gw, NGW, scr, lane);
                    tr_matrix(INP(20) + (size_t)e * D * DFE, D, DFE, (bf16*)WSP(WS_WMGU) + (size_t)e * 2 * DFE * D, D, 0, 2, base, gw, NGW, scr, lane);
                    tr_matrix(INP(21) + (size_t)e * DFE * D, DFE, D, (bf16*)WSP(WS_WMD) + (size_t)e * D * DFE, DFE, 0, 0, base, gw, NGW, scr, lane);
                }
                base = 0;
#endif
#pragma unroll 1
                for (int e = 0; e < NE; ++e) {
                    tr_matrix(INP(19) + (size_t)e * D * DFE, D, DFE, (bf16*)WSP(WS_WMGU) + (size_t)e * 2 * DFE * D, D, 0, 1, base, gw, NGW, scr, lane);
                    tr_matrix(INP(20) + (size_t)e * D * DFE, D, DFE, (bf16*)WSP(WS_WMGU) + (size_t)e * 2 * DFE * D, D, 0, 2, base, gw, NGW, scr, lane);
                    tr_matrix(INP(21) + (size_t)e * DFE * D, DFE, D, (bf16*)WSP(WS_WMD) + (size_t)e * D * DFE, DFE, 0, 0, base, gw, NGW, scr, lane);
                }
            }
            GRID_BAR(); STAMP(9);
            LAS int* TP = (LAS int*)(lds + LDSCTL_OFF + 1024);
            if (threadIdx.x == 0) { int acc_t = 0; unsigned* cnt = (unsigned*)WSP(WS_CTL) + CW_CNT;
                for (int e = 0; e < NE; ++e) { TP[e] = acc_t; acc_t += ((int)xb_ld(cnt + 64 * e) + 255) >> 8; }
                TP[NE] = acc_t; }
            __syncthreads();
            {
                PHASE_IDS();
                u32x4* ROUTE = (u32x4*)WSP(WS_ROUTE); const bf16* HX = (const bf16*)WSP(WS_HX); bf16* XY = (bf16*)WSP(WS_XY);
                u32x4 rn = ROUTE[gw < ML ? gw : 0]; u32x4 hn0 = *(const u32x4*)(HX + (size_t)(gw < ML ? gw : 0) * D + 8 * lane), hn1 = *(const u32x4*)(HX + (size_t)(gw < ML ? gw : 0) * D + 512 + 8 * lane);
                for (int row = gw; row < ML; row += NGW) { const u32x4 r = rn; const u32x4 h0 = hn0, h1 = hn1;
                    if (row + NGW < ML) { rn = ROUTE[row + NGW]; hn0 = *(const u32x4*)(HX + (size_t)(row + NGW) * D + 8 * lane); hn1 = *(const u32x4*)(HX + (size_t)(row + NGW) * D + 512 + 8 * lane); }
                    const unsigned p0 = (unsigned)(TP[r.x & 255u] * 256) + (r.x >> 8), p1 = (unsigned)(TP[r.y & 255u] * 256) + (r.y >> 8);
                    *(u32x4*)(XY + (size_t)p0 * D + 8 * lane) = h0; *(u32x4*)(XY + (size_t)p0 * D + 512 + 8 * lane) = h1;
                    *(u32x4*)(XY + (size_t)p1 * D + 8 * lane) = h0; *(u32x4*)(XY + (size_t)p1 * D + 512 + 8 * lane) = h1;
                    if (lane == 0) { u32x4 r2; r2.x = p0; r2.y = p1; r2.z = r.z; r2.w = r.w; ROUTE[row] = r2; } }
            }
            GRID_BAR(); STAMP(10);
            const int ntiles = __builtin_amdgcn_readfirstlane(TP[NE]);
#pragma unroll 1
            for (int t0 = 0; t0 < ntiles; t0 += MOE_CHUNK) { const int ntc = min(MOE_CHUNK, ntiles - t0);
                { pg8::Gemm g{D, D}; pg8::SchedMoeUp S;
#pragma unroll
                  for (int e = 0; e <= NE; ++e) S.T.pre[e] = __builtin_amdgcn_readfirstlane(TP[e]);
                  S.t0 = t0; S.ntc = ntc; S.G = fresh_s((int)gridDim.x); S.c = fresh_s((int)blockIdx.x); S.X = (const char*)WSP(WS_XY); S.W = (const char*)WSP(WS_WMGU);
                  pg8::EpiSwiglu E{(bf16*)WSP(WS_H), DFE};
                  pg8::gemm_phase<pg8::EpiSwiglu, pg8::SchedMoeUp>(lds, g, S, E);
#ifdef DUP_MOEUP
                  GRID_BAR(); pg8::gemm_phase<pg8::EpiSwiglu, pg8::SchedMoeUp>(lds, g, S, E);
#endif
                }
                GRID_BAR(); STAMP(11);
                { pg8::Gemm g{DFE, DFE}; pg8::SchedMoeDown S;
#pragma unroll
                  for (int e = 0; e <= NE; ++e) S.T.pre[e] = __builtin_amdgcn_readfirstlane(TP[e]);
                  const bool split = (ntc <= 8) && (t0 > 0);
                  S.t0 = t0; S.ntc = ntc; S.nsl = split ? 7 : 1; S.G = fresh_s((int)gridDim.x); S.c = fresh_s((int)blockIdx.x); S.H = (const char*)WSP(WS_H); S.W = (const char*)WSP(WS_WMD);
                  pg8::EpiBf16 E{split ? (bf16*)WSP(WS_PART) : (bf16*)WSP(WS_XY), D};
                  pg8::gemm_phase<pg8::EpiBf16, pg8::SchedMoeDown>(lds, g, S, E);
#ifdef DUP_MOEDOWN
                  GRID_BAR(); pg8::gemm_phase<pg8::EpiBf16, pg8::SchedMoeDown>(lds, g, S, E);
#endif
                }
                GRID_BAR(); STAMP(12);
            }
            {
            PHASE_IDS();
                const u32x4* ROUTE = (const u32x4*)WSP(WS_ROUTE); const bf16* XY = (const bf16*)WSP(WS_XY); const float* modl = (const float*)WSP(WS_MOD) + (size_t)5 * NMOD; float* OUT = OUTP; const float* fg = INP(22);
                const int ntl = __builtin_amdgcn_readfirstlane(TP[NE]), nrem = ntl & 63; const bool splitc = (nrem >= 1) && (nrem <= 8) && (ntl > 64); const unsigned rem_base = splitc ? (unsigned)(ntl - nrem) * 256u : 0xffffffffu;
                const bf16* PY = (const bf16*)WSP(WS_PART);
                LAS float* G2T = (LAS float*)lds; LAS float* FGT = (LAS float*)(lds + 16384);
                for (int i = tid; i < 4 * D; i += NWAVES * 64) G2T[i] = modl[(size_t)(i >> 10) * NMOD + 5 * D + (i & 1023)];
                for (int i = tid; i < D; i += NWAVES * 64) FGT[i] = fg[i];
                __syncthreads();
                u32x4 rn = ROUTE[gw < ML ? gw : 0];
                for (int row = gw; row < ML; row += NGW) { const u32x4 r = rn; if (row + NGW < ML) rn = ROUTE[row + NGW];
                    const float w0 = __uint_as_float(r.z), w1 = __uint_as_float(r.w); const int v = row >> 13;
                    LAS const float* g2 = G2T + v * D; float* xr = OUT + (size_t)row * D; float val[16]; float ss = 0.f;
#pragma unroll
                    for (int jj = 0; jj < 2; ++jj) { const int o = 8 * lane + 512 * jj;
                        float a0[8], a1[8];
                        if (r.x < rem_base && r.y < rem_base) {
                            const u32x4 y0 = *(const u32x4*)(XY + (size_t)r.x * D + o), y1 = *(const u32x4*)(XY + (size_t)r.y * D + o);
                            a0[0] = bflo(y0.x); a0[1] = bfhi(y0.x); a0[2] = bflo(y0.y); a0[3] = bfhi(y0.y); a0[4] = bflo(y0.z); a0[5] = bfhi(y0.z); a0[6] = bflo(y0.w); a0[7] = bfhi(y0.w);
                            a1[0] = bflo(y1.x); a1[1] = bfhi(y1.x); a1[2] = bflo(y1.y); a1[3] = bfhi(y1.y); a1[4] = bflo(y1.z); a1[5] = bfhi(y1.z); a1[6] = bflo(y1.w); a1[7] = bfhi(y1.w);
                        } else {
#pragma unroll
                            for (int t = 0; t < 2; ++t) { const unsigned p = t ? r.y : r.x; float* aa = t ? a1 : a0;
                                if (p >= rem_base) {
#pragma unroll
                                    for (int j = 0; j < 8; ++j) aa[j] = 0.f;
#pragma unroll 1
                                    for (int sl = 0; sl < 7; ++sl) { const u32x4 y = *(const u32x4*)(PY + ((size_t)sl * 2048 + (p - rem_base)) * D + o);
                                        aa[0] += bflo(y.x); aa[1] += bfhi(y.x); aa[2] += bflo(y.y); aa[3] += bfhi(y.y); aa[4] += bflo(y.z); aa[5] += bfhi(y.z); aa[6] += bflo(y.w); aa[7] += bfhi(y.w); }
                                } else { const u32x4 y = *(const u32x4*)(XY + (size_t)p * D + o);
                                    aa[0] = bflo(y.x); aa[1] = bfhi(y.x); aa[2] = bflo(y.y); aa[3] = bfhi(y.y); aa[4] = bflo(y.z); aa[5] = bfhi(y.z); aa[6] = bflo(y.w); aa[7] = bfhi(y.w); } }
                        }
                        const f32x4 xa = *(const f32x4*)(xr + o), xb = *(const f32x4*)(xr + o + 4), ga = *(const LAS f32x4*)(g2 + o), gb = *(const LAS f32x4*)(g2 + o + 4);
                        const float xv[8] = {xa.x, xa.y, xa.z, xa.w, xb.x, xb.y, xb.z, xb.w}, gv[8] = {ga.x, ga.y, ga.z, ga.w, gb.x, gb.y, gb.z, gb.w};
#pragma unroll
                        for (int j = 0; j < 8; ++j) { const float t = xv[j] + gv[j] * (w0 * a0[j] + w1 * a1[j]); val[8 * jj + j] = t; ss += t * t; } }
                    const float rstd = 1.0f / sqrtf(wave_sum(ss, lane) * (1.f / D) + EPS);
#pragma unroll
                    for (int jj = 0; jj < 2; ++jj) { const int o = 8 * lane + 512 * jj; const f32x4 fa = *(const LAS f32x4*)(FGT + o), fb = *(const LAS f32x4*)(FGT + o + 4);
                        *(f32x4*)(xr + o) = (f32x4){val[8 * jj] * rstd * fa.x, val[8 * jj + 1] * rstd * fa.y, val[8 * jj + 2] * rstd * fa.z, val[8 * jj + 3] * rstd * fa.w};
                        *(f32x4*)(xr + o + 4) = (f32x4){val[8 * jj + 4] * rstd * fb.x, val[8 * jj + 5] * rstd * fb.y, val[8 * jj + 6] * rstd * fb.z, val[8 * jj + 7] * rstd * fb.w}; }
                }
            }
#ifdef PROBE_GA
            STAMP(13);
            if (blockIdx.x == 0 && threadIdx.x == 0) { const unsigned dl = TSW[PROBE_GA] * PROBE_AMP; const unsigned long long t0 = __builtin_amdgcn_s_memrealtime();
                while ((unsigned)(__builtin_amdgcn_s_memrealtime() - t0) < dl) __builtin_amdgcn_s_sleep(8); }
#endif
        }
    }
}

extern "C" void kernel_launch(void* const* d_in, const int* in_sizes, int n_in, void* d_out, int out_size, void* d_ws, size_t ws_size, hipStream_t stream) {
    static int grid = 0;
    if (grid == 0) {
        if (n_in != 23 || out_size != ML * D || ws_size < WS_END) { fprintf(stderr, "kernel_launch: unexpected problem (n_in %d, out %d, ws %zu)\n", n_in, out_size, ws_size); grid = -1; return; }
        int dev = 0, cus = 0, per_cu = 0;
        if (hipGetDevice(&dev) != hipSuccess || hipDeviceGetAttribute(&cus, hipDeviceAttributeMultiprocessorCount, dev) != hipSuccess) { grid = -1; return; }
        if (hipFuncSetAttribute((const void*)fwd_kernel, hipFuncAttributeMaxDynamicSharedMemorySize, LDS_BYTES) != hipSuccess) { fprintf(stderr, "kernel_launch: hipFuncSetAttribute failed\n"); grid = -1; return; }
        if (hipOccupancyMaxActiveBlocksPerMultiprocessor(&per_cu, (const void*)fwd_kernel, NWAVES * 64, LDS_BYTES) != hipSuccess || per_cu < 1) { fprintf(stderr, "kernel_launch: occupancy query says %d\n", per_cu); }
        (void)hipGetLastError();
        grid = cus;
        if (grid != 256) { fprintf(stderr, "kernel_launch: built for 256 CUs, device has %d\n", cus); grid = -1; return; }
    }
    if (grid < 0) return;
    if (hipMemsetAsync((char*)d_ws + WS_CTL, 0, CTL_ZERO_BYTES, stream) != hipSuccess) return;
    Args a{};
    for (int i = 0; i < 23; ++i) a.in[i] = (const float*)d_in[i];
    a.out = (float*)d_out; a.ws = (unsigned char*)d_ws;
    hipLaunchKernelGGL(fwd_kernel, dim3(grid), dim3(NWAVES * 64), LDS_BYTES, stream, a);
}
```

```cpp
#include <hip/hip_runtime.h>
#include <cstdio>
#include <cstdint>

#define LAS __attribute__((address_space(3)))
#define GAS __attribute__((address_space(1)))
typedef unsigned short bf16;
typedef short bf16x8 __attribute__((ext_vector_type(8)));
typedef float f32x4 __attribute__((ext_vector_type(4)));
typedef float f32x2 __attribute__((ext_vector_type(2)));
typedef unsigned u32x4 __attribute__((ext_vector_type(4)));
typedef unsigned u32x2 __attribute__((ext_vector_type(2)));
typedef __bf16 bf16x2_t __attribute__((ext_vector_type(2)));

constexpr int D = 1024, BATCH = 4, SEQ = 8192, CTXL = 256;
constexpr int ML = BATCH * SEQ, MC = BATCH * CTXL, MT = ML + MC;
constexpr int ZP = 2688;
constexpr int PW = 5632, Q_OFF = 256, K_OFF = 768, V_OFF = 1280, U_OFF = 1792, B_OFF = 2048, C_OFF = 2304, G_OFF = 2560;
constexpr int DFF = 2816, DFE = 3584, NE = 8;
constexpr int VT_LD = SEQ + CTXL + 128;
constexpr int NMOD = 6 * D;
constexpr float EPS = 1e-6f;
constexpr int MOE_CHUNK = 64;

constexpr size_t MiB = 1u << 20;
constexpr size_t WS_CTL = 0, CTL_ZERO_BYTES = 1 * MiB;
constexpr size_t WS_MOD = 1 * MiB;
constexpr size_t WS_ROUTE = 1 * MiB + 256 * 1024;
constexpr size_t WS_TAB = 1 * MiB + 768 * 1024;
constexpr size_t WS_CP = 2 * MiB;
constexpr size_t WS_XC = 4 * MiB;
constexpr size_t WS_WIN = 8 * MiB;
constexpr size_t WS_WCAT = 30 * MiB;
constexpr size_t WS_WOUT = 34 * MiB;
constexpr size_t WS_WGU0 = 38 * MiB;
constexpr size_t WS_WD0 = 49 * MiB;
constexpr size_t WS_HX = 55 * MiB;
constexpr size_t WS_Z = 121 * MiB;
constexpr size_t WS_GQ = 295 * MiB;
constexpr size_t WS_VT = 394 * MiB;
constexpr size_t WS_R = 428 * MiB;
constexpr size_t WS_PART = 533 * MiB;
constexpr size_t WS_END = 577 * MiB;
constexpr size_t WS_G = WS_Z;
constexpr size_t WS_WMGU = 121 * MiB;
constexpr size_t WS_WMD = 233 * MiB;
constexpr size_t WS_H = 289 * MiB;
constexpr size_t WS_XY = 401 * MiB;
static_assert(WS_Z + (size_t)MT * ZP * 2 <= WS_GQ && WS_GQ + (size_t)MT * 3072 <= WS_VT && WS_VT + (size_t)BATCH * 8 * 64 * VT_LD * 2 <= WS_R && WS_R + (size_t)32 * MiB <= WS_PART && WS_XY + (size_t)67584 * 1024 * 2 <= WS_PART && WS_PART + (size_t)11 * MC * D * 4 <= WS_END && WS_H + (size_t)16384 * 3584 * 2 <= WS_XY && WS_G + (size_t)MT * DFF * 2 <= WS_VT, "ws map");
constexpr int CW_TMO = 0, CW_BAR = 4096, CW_CNT = 8192;

constexpr int RING_BYTES = 131072, LDSCTL_OFF = RING_BYTES, MISC_OFF = LDSCTL_OFF + 320, LDS_BYTES = 147456;
constexpr int NWAVES = 8;

__device__ __forceinline__ int fresh_s(int v) { asm volatile("" : "+s"(v)); return v; }
__device__ __forceinline__ int fresh_tid() { int t = threadIdx.x; asm volatile("" : "+v"(t)); return t; }
__device__ __forceinline__ unsigned pk2(float lo, float hi) { f32x2 v = {lo, hi}; bf16x2_t b = __builtin_convertvector(v, bf16x2_t); return __builtin_bit_cast(unsigned, b); }
__device__ __forceinline__ float bflo(unsigned w) { return __uint_as_float(w << 16); }
__device__ __forceinline__ float bfhi(unsigned w) { return __uint_as_float(w & 0xffff0000u); }
__device__ __forceinline__ float bf2f(bf16 b) { return __uint_as_float(((unsigned)b) << 16); }
__device__ __forceinline__ float fast_exp2(float x) { return __builtin_amdgcn_exp2f(x); }
__device__ __forceinline__ float sigmoidf_(float x) { return __builtin_amdgcn_rcpf(1.0f + __builtin_amdgcn_exp2f(-1.44269504088896f * x)); }

#ifndef RELAX_EPI
#define RELAX_EPI 0
#endif
namespace pg8 {
constexpr int BM = 256, BK = 64, HALF = 128, HTB = HALF * BK * 2, STAGE_BYTES = 8 * HTB, NXCD = 8, WGM = 8;
__host__ __device__ __forceinline__ int lds_byte(int r, int c) { const int st = (r >> 4) * 2 + (c >> 5), rr = r & 15, cc = c & 31, ob = rr * 64 + cc * 2; return st * 1024 + (ob ^ (((ob >> 9) & 1) << 5)); }
__host__ __device__ __forceinline__ void stage_rc(int b, int& R, int& C) { const int st = b / 1024, sb = b % 1024, swz = sb ^ (((sb >> 9) & 1) << 5); R = (st >> 1) * 16 + swz / 64; C = (st & 1) * 32 + (swz % 64) / 2; }
__host__ __device__ __forceinline__ int perm32(int rho) { const int n = rho >> 4, i = rho & 15; return 8 * (i >> 2) + 4 * n + (i & 3); }

struct Unit { int pm, pn; const char* A; const char* B; int nt; int aux; };
struct Gemm { int lda, ldb; };

__device__ __forceinline__ bool tile_map(long L, int nM, int nN, int& pm, int& pn) {
    const int nwg = nM * nN; if (L >= nwg) return false;
    int wgid = (int)L; { const int q = nwg / NXCD, r = nwg % NXCD, xcd = wgid % NXCD, off = wgid / NXCD; wgid = (xcd < r ? xcd * (q + 1) : r * (q + 1) + (xcd - r) * q) + off; }
    const int nig = WGM * nN, gid = wgid / nig, fm = gid * WGM, gsz = (nM - fm) < WGM ? (nM - fm) : WGM;
    pm = fm + ((wgid % nig) % gsz); pn = (wgid % nig) / gsz; return true;
}

template <class Epi, class Sched, bool ALIGN_EPI = true, bool SP2 = true>
__device__ __forceinline__ void gemm_phase(LAS unsigned char* lds, const Gemm g, const Sched& S, const Epi& E) {
    const int tid = fresh_tid(), wid = __builtin_amdgcn_readfirstlane(tid >> 6), lane = tid & 63, wr = wid >> 2, wc = wid & 3, fr = lane & 15, fq = lane >> 4;
    unsigned voffA[2], voffB[2];
#pragma unroll
    for (int i = 0; i < 2; ++i) { int R, C; stage_rc(tid * 16 + i * 8192, R, C); const int Rb = Epi::PERM ? ((R & ~31) + perm32(R & 31)) : R;
        voffA[i] = (unsigned)(R * g.lda + C) * 2u; voffB[i] = (unsigned)(Rb * g.ldb + C) * 2u; }
    const size_t kstep = (size_t)(BK * 2);
    const size_t hstepA = (size_t)HALF * g.lda * 2, hstepB = (size_t)HALF * g.ldb * 2;
    const unsigned ldsw = (unsigned)wid * 1024u;
    const int aoff = lds_byte(wr * 64 + fr, fq * 8), boff = lds_byte(wc * 32 + fr, fq * 8);
#define PG8_SA(b, h) (((b) * 2 + (h)) * HTB)
#define PG8_SB(b, h) ((4 + (b) * 2 + (h)) * HTB)
#define PG8_STAGE(bufoff, gbase, voff) do { _Pragma("unroll") for (int _i = 0; _i < 2; ++_i) \
        __builtin_amdgcn_global_load_lds((const unsigned*)((const char*)(gbase) + (voff)[_i]), (LAS unsigned*)(lds + (bufoff) + ldsw + _i * 8192), 16, 0, 0); } while (0)
#define PG8_LDA(dst, b, h) do { _Pragma("unroll") for (int m = 0; m < 4; ++m) _Pragma("unroll") for (int k = 0; k < 2; ++k) dst[m][k] = *(const LAS bf16x8*)(lds + PG8_SA(b, h) + aoff + m * 2048 + k * 1024); } while (0)
#define PG8_LDB(dst, b, h) do { _Pragma("unroll") for (int n = 0; n < 2; ++n) _Pragma("unroll") for (int k = 0; k < 2; ++k) dst[n][k] = *(const LAS bf16x8*)(lds + PG8_SB(b, h) + boff + n * 2048 + k * 1024); } while (0)
#define PG8_MMA(ai, bj, At, Bt) do { __builtin_amdgcn_s_setprio(1); _Pragma("unroll") for (int m = 0; m < 4; ++m) _Pragma("unroll") for (int n = 0; n < 2; ++n) _Pragma("unroll") for (int k = 0; k < 2; ++k) \
        acc[ai][bj][m][n] = __builtin_amdgcn_mfma_f32_16x16x32_bf16(Bt[n][k], At[m][k], acc[ai][bj][m][n], 0, 0, 0); __builtin_amdgcn_s_setprio(0); } while (0)
#define PG8_WAIT_V(n) asm volatile("s_waitcnt vmcnt(" #n ")" ::: "memory")
#define PG8_WAIT_L(n) asm volatile("s_waitcnt lgkmcnt(" #n ")" ::: "memory")
#define PG8_WAIT_VX(strict_) do { if constexpr (Epi::NST == 8) asm volatile("s_cmp_eq_u32 %0, 0\n\ts_cbranch_scc1 .Lrx_%=\n\ts_waitcnt vmcnt(8)\n.Lrx_%=:\n\ts_waitcnt vmcnt(16)" :: "s"(strict_) : "memory", "scc"); \
        else if constexpr (Epi::NST == 16) asm volatile("s_cmp_eq_u32 %0, 0\n\ts_cbranch_scc1 .Lrx_%=\n\ts_waitcnt vmcnt(8)\n.Lrx_%=:\n\ts_waitcnt vmcnt(24)" :: "s"(strict_) : "memory", "scc"); \
        else asm volatile("s_waitcnt vmcnt(8)" ::: "memory"); } while (0)
#define PG8_BAR __builtin_amdgcn_s_barrier()
#define PG8_SCHED __builtin_amdgcn_sched_barrier(0)
    Unit cur, nxt; int ui = 0;
    if (!S.next(0, cur)) return;
    f32x4 acc[2][2][4][2];
#pragma unroll
    for (int a = 0; a < 2; ++a)
#pragma unroll
        for (int b = 0; b < 2; ++b)
#pragma unroll
            for (int m = 0; m < 4; ++m)
#pragma unroll
                for (int n = 0; n < 2; ++n) acc[a][b][m][n] = (f32x4){0.f, 0.f, 0.f, 0.f};
    bf16x8 At[4][2], B0[2][2], B1[2][2];
    const char* cA = cur.A; const char* cB = cur.B;
    if constexpr (SP2) {
        PG8_STAGE(PG8_SB(0, 0), cB, voffB); PG8_STAGE(PG8_SB(0, 1), cB + hstepB, voffB); PG8_STAGE(PG8_SA(0, 0), cA, voffA); PG8_STAGE(PG8_SA(0, 1), cA + hstepA, voffA);
        if (wr == 1) PG8_BAR;
        PG8_WAIT_V(2); PG8_BAR;
        PG8_STAGE(PG8_SB(1, 0), cB + kstep, voffB); PG8_STAGE(PG8_SA(1, 0), cA + kstep, voffA); PG8_STAGE(PG8_SB(1, 1), cB + hstepB + kstep, voffB);
        PG8_WAIT_V(6); PG8_BAR;
    } else {
        PG8_STAGE(PG8_SB(0, 0), cB, voffB); PG8_STAGE(PG8_SA(0, 0), cA, voffA); PG8_STAGE(PG8_SB(0, 1), cB + hstepB, voffB); PG8_STAGE(PG8_SA(0, 1), cA + hstepA, voffA);
        if (wr == 1) PG8_BAR;
        PG8_WAIT_V(4); PG8_BAR;
        PG8_STAGE(PG8_SB(1, 0), cB + kstep, voffB); PG8_STAGE(PG8_SA(1, 0), cA + kstep, voffA); PG8_STAGE(PG8_SB(1, 1), cB + hstepB + kstep, voffB);
        PG8_WAIT_V(6); PG8_BAR;
    }
    for (;;) {
        const bool has_next = S.next(ui + 1, nxt);
        const char* nA = has_next ? nxt.A : cA; const char* nB = has_next ? nxt.B : cB;
        const int nt = cur.nt;
#define PG8_TRIP(tt, WA, WB) do { const bool last = ((tt) == nt - 2); PG8_SCHED; \
            const char* a1 = cA + (size_t)((tt) + 1) * kstep; \
            const char* a2 = last ? nA : cA + (size_t)((tt) + 2) * kstep; const char* b2 = last ? nB : cB + (size_t)((tt) + 2) * kstep; \
            const char* a3 = a2 + kstep; const char* b3 = b2 + kstep; \
            PG8_LDB(B0, 0, 0); PG8_LDB(B1, 0, 1); PG8_SCHED; PG8_LDA(At, 0, 0); PG8_STAGE(PG8_SA(1, 1), a1 + hstepA, voffA); \
            WA; PG8_WAIT_L(0); PG8_BAR; PG8_MMA(0, 0, At, B0); PG8_MMA(0, 1, At, B1); PG8_BAR; PG8_SCHED; \
            PG8_LDA(At, 0, 1); PG8_STAGE(PG8_SB(0, 0), b2, voffB); PG8_STAGE(PG8_SB(0, 1), b2 + hstepB, voffB); PG8_STAGE(PG8_SA(0, 0), a2, voffA); \
            WB; PG8_WAIT_L(0); PG8_BAR; PG8_MMA(1, 0, At, B0); PG8_MMA(1, 1, At, B1); PG8_BAR; PG8_SCHED; \
            PG8_LDB(B0, 1, 0); PG8_LDB(B1, 1, 1); PG8_SCHED; PG8_LDA(At, 1, 0); PG8_STAGE(PG8_SA(0, 1), a2 + hstepA, voffA); \
            PG8_WAIT_V(8); PG8_WAIT_L(0); PG8_BAR; PG8_MMA(0, 0, At, B0); PG8_MMA(0, 1, At, B1); PG8_BAR; PG8_SCHED; \
            PG8_LDA(At, 1, 1); PG8_STAGE(PG8_SB(1, 0), b3, voffB); PG8_STAGE(PG8_SB(1, 1), b3 + hstepB, voffB); PG8_STAGE(PG8_SA(1, 0), a3, voffA); \
            PG8_WAIT_V(8); PG8_WAIT_L(0); PG8_BAR; PG8_MMA(1, 0, At, B0); PG8_MMA(1, 1, At, B1); PG8_BAR; PG8_SCHED; } while (0)
        for (int t = 0; t < nt; t += 2) { const int strict = __builtin_amdgcn_readfirstlane((RELAX_EPI && Epi::NST > 0 && t == 0 && ui > 0) ? 0 : 1);
            PG8_TRIP(t, PG8_WAIT_VX(strict), PG8_WAIT_VX(strict)); }
#undef PG8_TRIP
        if constexpr (ALIGN_EPI) { if (wr == 0) PG8_BAR; }
        E(acc, cur, wr, wc, fr, fq);
        if (!has_next) break;
        if (E.zero_after(cur)) {
#pragma unroll
            for (int a = 0; a < 2; ++a)
#pragma unroll
                for (int b = 0; b < 2; ++b)
#pragma unroll
                    for (int m = 0; m < 4; ++m)
#pragma unroll
                        for (int n = 0; n < 2; ++n) acc[a][b][m][n] = (f32x4){0.f, 0.f, 0.f, 0.f};
        }
        cur = nxt; cA = nA; cB = nB; ++ui;
        if constexpr (ALIGN_EPI) { if (wr == 1) PG8_BAR; }
    }
    PG8_WAIT_V(0);
    if constexpr (!ALIGN_EPI) { if (wr == 0) PG8_BAR; }
    PG8_BAR;
#undef PG8_SA
#undef PG8_SB
#undef PG8_STAGE
#undef PG8_LDA
#undef PG8_LDB
#undef PG8_MMA
#undef PG8_WAIT_V
#undef PG8_WAIT_L
#undef PG8_WAIT_VX
#undef PG8_BAR
#undef PG8_SCHED
}

struct SchedPlain {
    int nM, nN, G, c, nt; const char* A; const char* B; size_t tsA, tsB;
    __device__ __forceinline__ void init(int M, int N, int K, const bf16* A_, int lda, const bf16* B_, int ldb, int G_, int c_) {
        nM = M / BM; nN = N / BM; G = G_; c = c_; nt = K / BK; A = (const char*)A_; B = (const char*)B_; tsA = (size_t)BM * lda * 2; tsB = (size_t)BM * ldb * 2; }
    __device__ __forceinline__ bool next(int i, Unit& u) const {
        if (!tile_map((long)i * G + c, nM, nN, u.pm, u.pn)) return false;
        u.A = A + (size_t)u.pm * tsA; u.B = B + (size_t)u.pn * tsB; u.nt = nt; u.aux = 0; return true; }
};
struct SchedMerge {
    int nM, G, c; const char* Z; const char* W;
    __device__ __forceinline__ bool next(int i, Unit& u) const {
        const int ii = i / 3, br = i - 3 * ii;
        if (!tile_map((long)ii * G + c, nM, 4, u.pm, u.pn)) return false;
        const int acol = br == 0 ? 0 : (br == 1 ? Q_OFF : B_OFF), kof = br == 0 ? 0 : (br == 1 ? 256 : 768);
        u.A = Z + ((size_t)u.pm * BM * ZP + acol) * 2; u.B = W + ((size_t)u.pn * BM * D + kof) * 2; u.nt = br == 1 ? 8 : 4; u.aux = br; return true; }
};
struct MoeTiles { int pre[NE + 1]; };
__device__ __forceinline__ int moe_expert(const MoeTiles& T, int tile) { int e = 0;
#pragma unroll
    for (int j = 1; j < NE; ++j) e += (tile >= T.pre[j]) ? 1 : 0; return e; }
struct SchedMoeUp {
    MoeTiles T; int t0, ntc, G, c; const char* X; const char* W;
    __device__ __forceinline__ bool next(int i, Unit& u) const {
        int pml; if (!tile_map((long)i * G + c, ntc, 28, pml, u.pn)) return false;
        const int tile = t0 + pml, e = moe_expert(T, tile);
        u.pm = pml; u.A = X + (size_t)tile * BM * D * 2; u.B = W + ((size_t)e * 7168 + (size_t)u.pn * BM) * D * 2; u.nt = 16; u.aux = 0; return true; }
};
struct SchedMoeDown {
    MoeTiles T; int t0, ntc, nsl, G, c; const char* H; const char* W;
    __device__ __forceinline__ bool next(int i, Unit& u) const {
        const long L = (long)i * G + c; const int per = ntc * 4; if (L >= (long)per * nsl) return false;
        const int sl = (int)(L / per); int pml; tile_map(L - (long)sl * per, ntc, 4, pml, u.pn);
        const int tile = t0 + pml, e = moe_expert(T, tile), ntk = 56 / nsl;
        u.pm = (nsl == 1) ? tile : 8 * sl + pml; u.nt = ntk; u.aux = sl;
        u.A = H + (size_t)pml * BM * DFE * 2 + (size_t)sl * ntk * 128; u.B = W + ((size_t)e * D + (size_t)u.pn * BM) * DFE * 2 + (size_t)sl * ntk * 128; return true; }
};

struct EpiInProj {
    static constexpr bool PERM = true; static constexpr int NST = 16;
    bf16* Z; bf16* VT; unsigned char* GQ;
    __device__ __forceinline__ bool zero_after(const Unit&) const { return true; }
    __device__ __forceinline__ void operator()(f32x4 (&acc)[2][2][4][2], const Unit& u, int wr, int wc, int fr_, int fq_) const {
        int fr = fr_, fq = fq_; asm volatile("" : "+v"(fr), "+v"(fq));
        const int row0 = u.pm * BM + wr * 64 + fr, col0 = u.pn * BM + wc * 32 + 8 * fq;
        const int kind = (u.pn == 1 || u.pn == 2) ? 1 : ((u.pn == 5 || u.pn == 6) ? 2 : (u.pn >= 10 ? 3 : 0));
        if (kind == 2) {
#pragma unroll
            for (int ai = 0; ai < 2; ++ai)
#pragma unroll
                for (int m = 0; m < 4; ++m) { const int row = row0 + ai * HALF + m * 16;
                    const int b = row < ML ? (row >> 13) : ((row - ML) >> 8), t = row < ML ? (row & 8191) : (SEQ + ((row - ML) & 255));
#pragma unroll
                    for (int bj = 0; bj < 2; ++bj)
#pragma unroll
                        for (int n = 0; n < 2; ++n)
#pragma unroll
                            for (int j = 0; j < 4; ++j) { const int vc = col0 + bj * HALF + 4 * n + j - V_OFF;
                                VT[((size_t)(b * 512 + vc)) * VT_LD + t] = (bf16)(pk2(acc[ai][bj][m][n][j], 0.f) & 0xffffu); } }
            return;
        }
        if (kind == 3) {
            unsigned char* gq_tile = GQ + ((size_t)(u.pm * 12 + (u.pn - 10)) * 8 + (wr * 4 + wc)) * 8192 + (fq * 16 + fr) * 8;
#pragma unroll
            for (int ai = 0; ai < 2; ++ai)
#pragma unroll
                for (int m = 0; m < 4; ++m) { unsigned char* rowp = gq_tile + ((ai * 4 + m) * 2) * 512;
#pragma unroll
                    for (int bj = 0; bj < 2; ++bj) { u32x2 w; w.x = 0u; w.y = 0u;
#pragma unroll
                        for (int j = 0; j < 4; ++j) { w.x |= (unsigned)(sigmoidf_(acc[ai][bj][m][0][j]) * 255.0f + 0.5f) << (8 * j); w.y |= (unsigned)(sigmoidf_(acc[ai][bj][m][1][j]) * 255.0f + 0.5f) << (8 * j); }
                        *(u32x2*)(rowp + bj * 512) = w; } }
            return;
        }
        const float qs = 0.125f * 1.44269504088896f;
#pragma unroll
        for (int ai = 0; ai < 2; ++ai)
#pragma unroll
            for (int m = 0; m < 4; ++m) { bf16* rowp = Z + (size_t)(row0 + ai * HALF + m * 16) * ZP + col0;
#pragma unroll
                for (int bj = 0; bj < 2; ++bj) { f32x4 v0 = acc[ai][bj][m][0], v1 = acc[ai][bj][m][1];
                    if (kind == 1) { v0 = v0 * qs; v1 = v1 * qs; }
                    u32x4 w; w.x = pk2(v0[0], v0[1]); w.y = pk2(v0[2], v0[3]); w.z = pk2(v1[0], v1[1]); w.w = pk2(v1[2], v1[3]);
                    *(u32x4*)(rowp + bj * HALF) = w; } }
    }
};
struct EpiMerge {
    static constexpr bool PERM = true; static constexpr int NST = 0;
    const unsigned char* GQ; bf16* O;
    __device__ __forceinline__ bool zero_after(const Unit& u) const { return u.aux == 2; }
    __device__ __forceinline__ void operator()(f32x4 (&acc)[2][2][4][2], const Unit& u, int wr, int wc, int fr_, int fq_) const {
        int fr = fr_, fq = fq_; asm volatile("" : "+v"(fr), "+v"(fq));
        const int row0 = u.pm * BM + wr * 64 + fr, col0 = u.pn * BM + wc * 32 + 8 * fq, br = u.aux;
        const unsigned char* gq_t = GQ + ((size_t)(u.pm * 12 + u.pn) * 8 + (wr * 4 + wc)) * 8192 + (fq * 16 + fr) * 8;
        u32x2 gc[16], gn[16];
#pragma unroll
        for (int i = 0; i < 16; ++i) { gc[i] = *(const u32x2*)(gq_t + (size_t)br * 4 * 65536 + i * 512); gn[i] = (br < 2) ? *(const u32x2*)(gq_t + (size_t)(br + 1) * 4 * 65536 + i * 512) : gc[i]; }
#pragma unroll
        for (int ai = 0; ai < 2; ++ai)
#pragma unroll
            for (int m = 0; m < 4; ++m) { const size_t row = (size_t)(row0 + ai * HALF + m * 16);
#pragma unroll
                for (int bj = 0; bj < 2; ++bj) { const int col = col0 + bj * HALF, i = (ai * 4 + m) * 2 + bj;
                    float f[8];
#pragma unroll
                    for (int j = 0; j < 4; ++j) { f[j] = fmaxf((float)((gc[i].x >> (8 * j)) & 255u), 0.5f); f[4 + j] = fmaxf((float)((gc[i].y >> (8 * j)) & 255u), 0.5f); }
                    if (br < 2) {
#pragma unroll
                        for (int j = 0; j < 4; ++j) { f[j] *= __builtin_amdgcn_rcpf(fmaxf((float)((gn[i].x >> (8 * j)) & 255u), 0.5f)); f[4 + j] *= __builtin_amdgcn_rcpf(fmaxf((float)((gn[i].y >> (8 * j)) & 255u), 0.5f)); } }
                    else {
#pragma unroll
                        for (int j = 0; j < 8; ++j) f[j] *= (1.0f / 255.0f); }
#pragma unroll
                    for (int j = 0; j < 4; ++j) { acc[ai][bj][m][0][j] *= f[j]; acc[ai][bj][m][1][j] *= f[4 + j]; }
                    if (br == 2) { const f32x4 v0 = acc[ai][bj][m][0], v1 = acc[ai][bj][m][1];
                        u32x4 w; w.x = pk2(v0[0], v0[1]); w.y = pk2(v0[2], v0[3]); w.z = pk2(v1[0], v1[1]); w.w = pk2(v1[2], v1[3]);
                        *(u32x4*)(O + row * D + col) = w; } } }
    }
};
struct EpiResid {
    static constexpr bool PERM = false; static constexpr int NST = 16;
    const float* xl_in; const float* xc_in; float* xl_out; float* xc_out; const float* gate; float* part;
    __device__ __forceinline__ bool zero_after(const Unit&) const { return true; }
    __device__ __forceinline__ void operator()(f32x4 (&acc)[2][2][4][2], const Unit& u, int wr, int wc, int fr_, int fq_) const {
        int fr = fr_, fq = fq_; asm volatile("" : "+v"(fr), "+v"(fq));
        const int rt = u.pm * BM, col0 = u.pn * BM + wc * 32 + 4 * fq;
        const bool lat = rt < ML; const int v = lat ? (rt >> 13) : 4;
        const float* xin = lat ? xl_in + (size_t)rt * D : xc_in + (size_t)(rt - ML) * D; float* xout = lat ? xl_out + (size_t)rt * D : xc_out + (size_t)(rt - ML) * D;
        f32x4 gv[2][2];
#pragma unroll
        for (int bj = 0; bj < 2; ++bj)
#pragma unroll
            for (int n = 0; n < 2; ++n) gv[bj][n] = *(const f32x4*)(gate + (size_t)v * NMOD + col0 + bj * HALF + n * 16);
        if (u.aux > 0) {
            float* po = part + ((size_t)(u.aux - 1) * MC + (rt - ML)) * D;
#pragma unroll
            for (int ai = 0; ai < 2; ++ai)
#pragma unroll
                for (int m = 0; m < 4; ++m) { const size_t off = (size_t)(wr * 64 + fr + ai * HALF + m * 16) * D + col0;
#pragma unroll
                    for (int bj = 0; bj < 2; ++bj)
#pragma unroll
                        for (int n = 0; n < 2; ++n) *(f32x4*)(po + off + bj * HALF + n * 16) = gv[bj][n] * acc[ai][bj][m][n]; }
            return;
        }
#pragma unroll
        for (int ai = 0; ai < 2; ++ai) {
            f32x4 xi[4][2][2];
#pragma unroll
            for (int m = 0; m < 4; ++m) { const size_t off = (size_t)(wr * 64 + fr + ai * HALF + m * 16) * D + col0;
#pragma unroll
                for (int bj = 0; bj < 2; ++bj)
#pragma unroll
                    for (int n = 0; n < 2; ++n) xi[m][bj][n] = *(const f32x4*)(xin + off + bj * HALF + n * 16); }
#pragma unroll
            for (int m = 0; m < 4; ++m) { const size_t off = (size_t)(wr * 64 + fr + ai * HALF + m * 16) * D + col0;
#pragma unroll
                for (int bj = 0; bj < 2; ++bj)
#pragma unroll
                    for (int n = 0; n < 2; ++n) *(f32x4*)(xout + off + bj * HALF + n * 16) = xi[m][bj][n] + gv[bj][n] * acc[ai][bj][m][n]; }
        }
    }
};
struct SchedSplitCtx {
    int G, c, ntK, do_ctx; const char* A; const char* B; size_t tsA, tsB;
    __device__ __forceinline__ bool next(int i, Unit& u) const {
        const long L = (long)i * G + c; if (L >= 512 && !do_ctx) return false;
        if (L < 512) { tile_map(L, 128, 4, u.pm, u.pn); u.A = A + (size_t)u.pm * tsA; u.B = B + (size_t)u.pn * tsB; u.nt = ntK; u.aux = 0; return true; }
        const int j = (int)(L - 512), ns = ntK >> 2;
        if (j >= 16 * ns) return false;
        const int ks = j >> 4, tile = j & 15; u.pm = 128 + (tile >> 2); u.pn = tile & 3;
        u.A = A + (size_t)u.pm * tsA + (size_t)ks * 512; u.B = B + (size_t)u.pn * tsB + (size_t)ks * 512; u.nt = 4; u.aux = 1 + ks; return true; }
};
struct EpiSwiglu {
    static constexpr bool PERM = true; static constexpr int NST = 8;
    bf16* O; int ldo;
    __device__ __forceinline__ bool zero_after(const Unit&) const { return true; }
    __device__ __forceinline__ void operator()(f32x4 (&acc)[2][2][4][2], const Unit& u, int wr, int wc, int fr_, int fq_) const {
        int fr = fr_, fq = fq_; asm volatile("" : "+v"(fr), "+v"(fq));
        const int row0 = u.pm * BM + wr * 64 + fr, col0 = u.pn * HALF + wc * 32 + 8 * fq;
#pragma unroll
        for (int ai = 0; ai < 2; ++ai)
#pragma unroll
            for (int m = 0; m < 4; ++m) { bf16* rowp = O + (size_t)(row0 + ai * HALF + m * 16) * ldo + col0;
                float o[8];
#pragma unroll
                for (int n = 0; n < 2; ++n)
#pragma unroll
                    for (int j = 0; j < 4; ++j) { const float gt = acc[ai][0][m][n][j], up = acc[ai][1][m][n][j]; o[4 * n + j] = gt * sigmoidf_(gt) * up; }
                u32x4 w; w.x = pk2(o[0], o[1]); w.y = pk2(o[2], o[3]); w.z = pk2(o[4], o[5]); w.w = pk2(o[6], o[7]);
                *(u32x4*)rowp = w; }
    }
};
struct EpiBf16 {
    static constexpr bool PERM = true; static constexpr int NST = 16;
    bf16* O; int ldo;
    __device__ __forceinline__ bool zero_after(const Unit&) const { return true; }
    __device__ __forceinline__ void operator()(f32x4 (&acc)[2][2][4][2], const Unit& u, int wr, int wc, int fr_, int fq_) const {
        int fr = fr_, fq = fq_; asm volatile("" : "+v"(fr), "+v"(fq));
        const int row0 = u.pm * BM + wr * 64 + fr, col0 = u.pn * BM + wc * 32 + 8 * fq;
#pragma unroll
        for (int ai = 0; ai < 2; ++ai)
#pragma unroll
            for (int m = 0; m < 4; ++m) { bf16* rowp = O + (size_t)(row0 + ai * HALF + m * 16) * ldo + col0;
#pragma unroll
                for (int bj = 0; bj < 2; ++bj) { const f32x4 v0 = acc[ai][bj][m][0], v1 = acc[ai][bj][m][1];
                    u32x4 w; w.x = pk2(v0[0], v0[1]); w.y = pk2(v0[2], v0[3]); w.z = pk2(v1[0], v1[1]); w.w = pk2(v1[2], v1[3]);
                    *(u32x4*)(rowp + bj * HALF) = w; } }
    }
};
}

typedef GAS unsigned gu32;
#define RLX_AGENT __ATOMIC_RELAXED, __HIP_MEMORY_SCOPE_AGENT
#define LDS_WAIT() asm volatile("s_waitcnt lgkmcnt(0)" ::: "memory")
#define VM_WAIT() asm volatile("s_waitcnt vmcnt(0)" ::: "memory")
#define MFMA16(a, b, c) __builtin_amdgcn_mfma_f32_16x16x32_bf16((a), (b), (c), 0, 0, 0)

#define XB_TMO      128
#define XB_XCNT(j)  (256  + 64 * (j))
#define XB_XSUB(j)  (1280 + 64 * (j))
#define XB_XGEN(j)  (2304 + 64 * (j))
#define XB_TOP      3328
#define XB_TOPGEN   3392
#define XCD_BAR_WORDS 3456
#define XB_SPIN_CAP (1u << 18)
__device__ __forceinline__ unsigned xb_ld(unsigned* p)              { return __hip_atomic_load(p, __ATOMIC_RELAXED, __HIP_MEMORY_SCOPE_AGENT); }
__device__ __forceinline__ unsigned xb_add(unsigned* p, unsigned v) { return __hip_atomic_fetch_add(p, v, __ATOMIC_RELAXED, __HIP_MEMORY_SCOPE_AGENT); }
__device__ __forceinline__ unsigned xb_xcc_id() { return (unsigned)__builtin_amdgcn_s_getreg((3 << 11) | 20) & 0xFu; }
#define XB_SPIN(cond, bar) do { unsigned _sp = 0; while (cond) { __builtin_amdgcn_s_sleep(1); \
    if ((++_sp & 255u) == 0u) { if (xb_ld(&(bar)[XB_TMO])) break; if (_sp > XB_SPIN_CAP) { atomicAdd(&(bar)[XB_TMO], 1u); break; } } } } while (0)
struct XcdBarrier { unsigned* bar; unsigned x; volatile LAS unsigned* st; };
__device__ __forceinline__ XcdBarrier xcd_barrier_post(unsigned* bar, volatile LAS unsigned* st) {
    XcdBarrier b; b.bar = bar; b.x = xb_xcc_id(); b.st = st;
    if (threadIdx.x == 0) (void)xb_add(&bar[XB_XCNT(b.x)], 1u);
    return b;
}
__device__ __forceinline__ void xcd_barrier_complete(unsigned* bar, unsigned x, unsigned& nloc, unsigned& nx) {
    const unsigned G = gridDim.x * gridDim.y * gridDim.z;
    unsigned sum, cnt, mine, sp = 0u;
    for (;;) {
        sum = 0u; cnt = 0u; mine = 0u;
#pragma unroll
        for (unsigned j = 0; j < 16; ++j) { const unsigned c = xb_ld(&bar[XB_XCNT(j)]); sum += c; cnt += (c > 0u) ? 1u : 0u; mine = (j == x) ? c : mine; }
        if (sum == G) break;
        __builtin_amdgcn_s_sleep(1);
        if ((++sp & 255u) == 0u) { if (xb_ld(&bar[XB_TMO])) break; if (sp > XB_SPIN_CAP) { atomicAdd(&bar[XB_TMO], 1u); break; } }
    }
    nloc = mine > 0u ? mine : 1u; nx = cnt > 0u ? cnt : 1u;
}
__device__ __forceinline__ void xcd_barrier(const XcdBarrier& b) {
    asm volatile("s_waitcnt vmcnt(0)" ::: "memory");
    __syncthreads();
    if (threadIdx.x == 0) {
        unsigned* bar = b.bar; unsigned bx_ = b.x;
        asm volatile("" : "+s"(bar), "+s"(bx_));
        __builtin_amdgcn_s_waitcnt(0);
        unsigned nloc = b.st[0], nx = b.st[1];
        if (nloc == 0u) { xcd_barrier_complete(bar, bx_, nloc, nx); b.st[0] = nloc; b.st[1] = nx; }
        const unsigned old = xb_add(&bar[XB_XSUB(bx_)], 1u);
        const unsigned gen = old / nloc;
        if (old + 1u == (gen + 1u) * nloc) {
            __builtin_amdgcn_fence(__ATOMIC_RELEASE, "agent");
            asm volatile("s_waitcnt vmcnt(0)" ::: "memory");
            const unsigned og = xb_add(&bar[XB_TOP], 1u);
            const unsigned tg = og / nx;
            if (og + 1u == (tg + 1u) * nx) xb_add(&bar[XB_TOPGEN], 1u);
            else XB_SPIN(xb_ld(&bar[XB_TOPGEN]) == tg, bar);
            __builtin_amdgcn_fence(__ATOMIC_ACQUIRE, "agent");
            xb_add(&bar[XB_XGEN(bx_)], 1u);
            asm volatile("s_waitcnt vmcnt(0)" ::: "memory");
        } else {
            XB_SPIN(xb_ld(&bar[XB_XGEN(bx_)]) == gen, bar);
            __builtin_amdgcn_fence(__ATOMIC_ACQUIRE, "agent");
            asm volatile("s_waitcnt vmcnt(0)" ::: "memory");
        }
    }
    __syncthreads();
}

__device__ __forceinline__ float shx(float v, int o, int lane) { return __int_as_float(__builtin_amdgcn_ds_bpermute((lane ^ o) << 2, __float_as_int(v))); }
__device__ __forceinline__ float wave_sum(float v, int lane) {
#pragma unroll
    for (int o = 1; o < 64; o <<= 1) v += shx(v, o, lane);
    return v;
}

__device__ __forceinline__ void transpose_item(const float* W, int N, bf16* WT, int ldk, int dst_row0, int dst_k0, int k0, int n0, LAS float* scr, int lane) {
    f32x4 v[8];
#pragma unroll
    for (int i = 0; i < 8; ++i) v[i] = *(const f32x4*)(W + (size_t)(k0 + (lane >> 3) + 8 * i) * N + n0 + 4 * (lane & 7));
#pragma unroll
    for (int i = 0; i < 8; ++i) { LAS float* d = scr + ((lane >> 3) + 8 * i) * 33 + 4 * (lane & 7); d[0] = v[i].x; d[1] = v[i].y; d[2] = v[i].z; d[3] = v[i].w; }
    LDS_WAIT(); asm volatile("" ::: "memory");
    const int c = lane & 7;
#pragma unroll
    for (int j = 0; j < 4; ++j) { const int n = (lane >> 3) + 8 * j; const LAS float* s = scr + (8 * c) * 33 + n;
        u32x4 o; o.x = pk2(s[0 * 33], s[1 * 33]); o.y = pk2(s[2 * 33], s[3 * 33]); o.z = pk2(s[4 * 33], s[5 * 33]); o.w = pk2(s[6 * 33], s[7 * 33]);
        *(u32x4*)(WT + (size_t)(dst_row0 + n) * ldk + dst_k0 + k0 + 8 * c) = o; }
    LDS_WAIT(); asm volatile("" ::: "memory");
}
__device__ __forceinline__ void tr_matrix(const float* W, int K, int N, bf16* WT, int ldk, int dst_k0, int mode, int& base, int gw, int NGW, LAS float* scr, int lane) {
    const int nnb = N / 32, items = (K / 64) * nnb;
    const int first = (gw - base % NGW + NGW) % NGW;
    for (int it = first; it < items; it += NGW) { const int kb = it / nnb, nb = it - kb * nnb, n0 = 32 * nb;
        const int dr = mode == 0 ? n0 : (256 * (n0 >> 7) + (n0 & 127) + (mode == 2 ? 128 : 0));
        transpose_item(W, N, WT, ldk, dr, dst_k0, 64 * kb, n0, scr, lane); }
    base += items;
}

__device__ __forceinline__ void norm_tables(LAS float* A, LAS float* S, const float* g, const float* mod, int shift_off, int scale_off, int tid) {
    for (int i = tid; i < 5 * D; i += NWAVES * 64) { const int v = i >> 10, k = i & 1023; A[i] = g[k] * (1.0f + mod[(size_t)v * NMOD + scale_off + k]); S[i] = mod[(size_t)v * NMOD + shift_off + k]; }
}
__device__ __forceinline__ void norm_load2(const float* x0, const float* x1, int lane, f32x4 (&v0)[4], f32x4 (&v1)[4]) {
#pragma unroll
    for (int j = 0; j < 4; ++j) { v0[j] = *(const f32x4*)(x0 + 4 * lane + 256 * j); v1[j] = *(const f32x4*)(x1 + 4 * lane + 256 * j); }
}
__device__ __forceinline__ void norm_finish2(const f32x4 (&v0)[4], const f32x4 (&v1)[4], LAS const float* A0, LAS const float* S0, LAS const float* A1, LAS const float* S1, bf16* o0, bf16* o1, bool st1, int lane,
                                             f32x4 (&h0)[4], f32x4 (&h1)[4]) {
    float s0 = 0.f, s1 = 0.f;
#pragma unroll
    for (int j = 0; j < 4; ++j) { s0 += (v0[j].x * v0[j].x + v0[j].y * v0[j].y) + (v0[j].z * v0[j].z + v0[j].w * v0[j].w); s1 += (v1[j].x * v1[j].x + v1[j].y * v1[j].y) + (v1[j].z * v1[j].z + v1[j].w * v1[j].w); }
#pragma unroll
    for (int o = 1; o < 64; o <<= 1) { s0 += shx(s0, o, lane); s1 += shx(s1, o, lane); }
    const float r0 = 1.0f / sqrtf(s0 * (1.f / D) + EPS), r1 = 1.0f / sqrtf(s1 * (1.f / D) + EPS);
#pragma unroll
    for (int j = 0; j < 4; ++j) { const int o = 4 * lane + 256 * j;
        h0[j] = v0[j] * r0 * *(const LAS f32x4*)(A0 + o) + *(const LAS f32x4*)(S0 + o);
        h1[j] = v1[j] * r1 * *(const LAS f32x4*)(A1 + o) + *(const LAS f32x4*)(S1 + o);
        u32x2 w; w.x = pk2(h0[j].x, h0[j].y); w.y = pk2(h0[j].z, h0[j].w); *(u32x2*)(o0 + o) = w;
        if (st1) { u32x2 w1; w1.x = pk2(h1[j].x, h1[j].y); w1.y = pk2(h1[j].z, h1[j].w); *(u32x2*)(o1 + o) = w1; } }
}
__device__ __forceinline__ void norm_rows2(const float* x0, const float* x1, LAS const float* A0, LAS const float* S0, LAS const float* A1, LAS const float* S1, bf16* o0, bf16* o1, bool st1, int lane,
                                           f32x4 (&h0)[4], f32x4 (&h1)[4]) {
    f32x4 v0[4], v1[4]; norm_load2(x0, x1, lane, v0, v1); norm_finish2(v0, v1, A0, S0, A1, S1, o0, o1, st1, lane, h0, h1);
}
template <int NA, int NB>
__device__ __forceinline__ void norm_ctx_rows(const float* xc, const float* partA, const float* partB, LAS const float* TA_, LAS const float* TS_, bf16* HX, int gw, int NGW, int lane) {
    for (int r = gw; r < MC; r += NGW) {
        f32x4 v[4], pa[NA > 0 ? NA : 1][4], pb[NB > 0 ? NB : 1][4];
#pragma unroll
        for (int j = 0; j < 4; ++j) v[j] = *(const f32x4*)(xc + (size_t)r * D + 4 * lane + 256 * j);
#pragma unroll
        for (int p = 0; p < NA; ++p)
#pragma unroll
            for (int j = 0; j < 4; ++j) pa[p][j] = *(const f32x4*)(partA + ((size_t)p * MC + r) * D + 4 * lane + 256 * j);
#pragma unroll
        for (int p = 0; p < NB; ++p)
#pragma unroll
            for (int j = 0; j < 4; ++j) pb[p][j] = *(const f32x4*)(partB + ((size_t)p * MC + r) * D + 4 * lane + 256 * j);
#pragma unroll
        for (int p = 0; p < NA; ++p)
#pragma unroll
            for (int j = 0; j < 4; ++j) v[j] += pa[p][j];
#pragma unroll
        for (int p = 0; p < NB; ++p)
#pragma unroll
            for (int j = 0; j < 4; ++j) v[j] += pb[p][j];
        f32x4 h0[4], h1[4]; norm_finish2(v, v, TA_ + 4 * D, TS_ + 4 * D, TA_ + 4 * D, TS_ + 4 * D, HX + (size_t)(ML + r) * D, HX + (size_t)(ML + r) * D, false, lane, h0, h1);
    }
}
__device__ __forceinline__ void norm_phase_rows(const float* xl, const float* xc, int M, LAS const float* TA_, LAS const float* TS_, bf16* HX, int gw, int NGW, int lane) {
    f32x4 va[4], vb[4];
    { const int row = gw, rowb = (row + NGW < M) ? row + NGW : row;
      if (row < M) norm_load2(row < ML ? xl + (size_t)row * D : xc + (size_t)(row - ML) * D, rowb < ML ? xl + (size_t)rowb * D : xc + (size_t)(rowb - ML) * D, lane, va, vb); }
    for (int row = gw; row < M; row += 2 * NGW) { const int row1 = row + NGW; const bool has1 = row1 < M; const int rowb = has1 ? row1 : row;
        const int va_ = row < ML ? (row >> 13) : 4, vb_ = rowb < ML ? (rowb >> 13) : 4;
        f32x4 na[4], nb[4]; const int nrow = row + 2 * NGW;
        if (nrow < M) { const int nrowb = (nrow + NGW < M) ? nrow + NGW : nrow;
            norm_load2(nrow < ML ? xl + (size_t)nrow * D : xc + (size_t)(nrow - ML) * D, nrowb < ML ? xl + (size_t)nrowb * D : xc + (size_t)(nrowb - ML) * D, lane, na, nb); }
        else {
#pragma unroll
            for (int j = 0; j < 4; ++j) { na[j] = va[j]; nb[j] = vb[j]; } }
        f32x4 ha[4], hb[4]; norm_finish2(va, vb, TA_ + va_ * D, TS_ + va_ * D, TA_ + vb_ * D, TS_ + vb_ * D, HX + (size_t)row * D, HX + (size_t)rowb * D, has1, lane, ha, hb);
#pragma unroll
        for (int j = 0; j < 4; ++j) { va[j] = na[j]; vb[j] = nb[j]; }
    }
}

template <typename T> __device__ __forceinline__ T ldg_u(const void* ubase, unsigned voff) { return *(const T*)((const char*)ubase + voff); }
#define RFL(x) __builtin_amdgcn_readfirstlane(x)
typedef __amdgpu_buffer_rsrc_t rsrc_t;
__device__ __forceinline__ float quad_max(float v) {
    { auto rr = __builtin_amdgcn_permlane16_swap(__float_as_uint(v), __float_as_uint(v), false, false); v = fmaxf(__uint_as_float(rr[0]), __uint_as_float(rr[1])); }
    { auto rr = __builtin_amdgcn_permlane32_swap(__float_as_uint(v), __float_as_uint(v), false, false); v = fmaxf(__uint_as_float(rr[0]), __uint_as_float(rr[1])); }
    return v; }
__device__ __forceinline__ float quad_sum(float v) {
    { auto rr = __builtin_amdgcn_permlane16_swap(__float_as_uint(v), __float_as_uint(v), false, false); v = __uint_as_float(rr[0]) + __uint_as_float(rr[1]); }
    { auto rr = __builtin_amdgcn_permlane32_swap(__float_as_uint(v), __float_as_uint(v), false, false); v = __uint_as_float(rr[0]) + __uint_as_float(rr[1]); }
    return v; }
__device__ __forceinline__ bf16x8 bld128(rsrc_t rs, unsigned voff, int soff) { return __builtin_bit_cast(bf16x8, __builtin_amdgcn_raw_buffer_load_b128(rs, (int)voff, soff, 0)); }
constexpr int ATT_CK = 0, ATT_CV = 36864, ATT_RP = 70656, ATT_WK = 74496, ATT_WV = 92928, ATT_END = 111360;
template <bool WINDOW>
__device__ __forceinline__ void att_step(const bf16x8 (&kf)[4], const bf16x8 (&vf)[4], const bf16x8 (&qf)[2], f32x4 (&o)[4], float& mrun, float& lrun, LAS const float* rp, const float (&mk)[2][4]) {
    f32x4 t0 = MFMA16(kf[0], qf[0], ((f32x4){0.f, 0.f, 0.f, 0.f})); t0 = MFMA16(kf[1], qf[1], t0);
    f32x4 t1 = MFMA16(kf[2], qf[0], ((f32x4){0.f, 0.f, 0.f, 0.f})); t1 = MFMA16(kf[3], qf[1], t1);
    if (WINDOW) {
#pragma unroll
        for (int j = 0; j < 4; ++j) { t0[j] = (t0[j] + rp[j]) + mk[0][j]; t1[j] = (t1[j] + rp[4 + j]) + mk[1][j]; }
    }
    float cm = fmaxf(fmaxf(fmaxf(t0[0], t0[1]), fmaxf(t0[2], t0[3])), fmaxf(fmaxf(t1[0], t1[1]), fmaxf(t1[2], t1[3])));
    cm = quad_max(cm);
    const float mnew = fmaxf(mrun, cm), alpha = fast_exp2(mrun - mnew);
    float ls = 0.f;
#pragma unroll
    for (int j = 0; j < 4; ++j) { t0[j] = fast_exp2(t0[j] - mnew); t1[j] = fast_exp2(t1[j] - mnew); ls += t0[j] + t1[j]; }
    lrun = lrun * alpha + ls; mrun = mnew;
    u32x4 pw; pw.x = pk2(t0[0], t0[1]); pw.y = pk2(t0[2], t0[3]); pw.z = pk2(t1[0], t1[1]); pw.w = pk2(t1[2], t1[3]);
    const bf16x8 pf = __builtin_bit_cast(bf16x8, pw);
#pragma unroll
    for (int dt = 0; dt < 4; ++dt) { o[dt] = o[dt] * alpha; o[dt] = MFMA16(vf[dt], pf, o[dt]); }
}
template <int NU>
__device__ __forceinline__ void att_ctx(LAS const unsigned char* lds, const bf16x8 (&qf)[4][2], f32x4 (&o)[4][4], float (&mrun)[4], float (&lrun)[4], const float (&mk)[2][4], int n, int q) {
    const unsigned kl = (unsigned)((8 * (n >> 2) + (n & 3)) * 144 + 16 * q), vl = (unsigned)(n * 528 + 16 * q);
#pragma unroll 1
    for (int st = 0; st < 8; ++st) {
        bf16x8 kf[4], vf[4];
        LAS const unsigned char* kp = lds + ATT_CK + st * (32 * 144) + kl; LAS const unsigned char* vp = lds + ATT_CV + st * 64 + vl;
        kf[0] = *(const LAS bf16x8*)kp; kf[1] = *(const LAS bf16x8*)(kp + 64); kf[2] = *(const LAS bf16x8*)(kp + 4 * 144); kf[3] = *(const LAS bf16x8*)(kp + 4 * 144 + 64);
#pragma unroll
        for (int dt = 0; dt < 4; ++dt) vf[dt] = *(const LAS bf16x8*)(vp + dt * (16 * 528));
#pragma unroll
        for (int u = 0; u < NU; ++u) att_step<false>(kf, vf, qf[u], o[u], mrun[u], lrun[u], (LAS const float*)lds, mk);
    }
}
template <bool DUMMY = false>
__device__ __forceinline__ void attn_phase(LAS unsigned char* lds, bf16* Z, const bf16* VT, const float* rpb_g  , bool do_ctx_queries, int vcu, int tid, bf16* dummy = nullptr) {
    const int lane = tid & 63, wave = RFL(tid >> 6), n = lane & 15, q = lane >> 4;
    const int bh = vcu >> 3, jj = vcu & 7, b = bh >> 3, h = bh & 7;
    const rsrc_t rsZ = __builtin_amdgcn_make_buffer_rsrc((void*)Z, (short)0, (int)((size_t)MT * ZP * 2), 0x00020000);
    const rsrc_t rsV = __builtin_amdgcn_make_buffer_rsrc((void*)VT, (short)0, (int)((size_t)BATCH * 8 * 64 * VT_LD * 2), 0x00020000);
#pragma unroll
    for (int i = 0; i < 4; ++i) { const int id = tid + 512 * i;
        { const int key = id >> 3, p = id & 7; *(LAS bf16x8*)(lds + ATT_CK + key * 144 + p * 16) = bld128(rsZ, (unsigned)((key * ZP + 8 * p) * 2), ((ML + b * CTXL) * ZP + K_OFF + h * 64) * 2); }
        { const int d = id >> 5, p = id & 31; *(LAS bf16x8*)(lds + ATT_CV + d * 528 + p * 16) = bld128(rsV, (unsigned)((d * VT_LD + 8 * p) * 2), (bh * 64 * VT_LD + SEQ) * 2); } }
    for (int i = tid; i < 15 * 64; i += 512) { const int dc = (i & 63) - 16; ((LAS float*)(lds + ATT_RP))[i] = (dc >= 0 && dc <= 30) ? rpb_g[(h * 15 + (i >> 6)) * 31 + dc] * 1.44269504088896f : 0.f; }
    __syncthreads();
    const int a = (wave & 3) * 16, par = wave >> 2, s0 = min(max(a - 8, 0), 32), qc = a + n, cs = min(max(qc - 8, 0), 48);
    float mk[2][4];
#pragma unroll
    for (int hf = 0; hf < 2; ++hf)
#pragma unroll
        for (int j = 0; j < 4; ++j) { const int kc = s0 + 8 * q + 4 * hf + j; mk[hf][j] = ((kc >= cs) && (kc < cs + 16)) ? 0.f : -INFINITY; }
    const unsigned qlane = (unsigned)(n * ZP + 8 * q) * 2u, olane = (unsigned)(n * ZP + 4 * q) * 2u;
    const unsigned wkl = (unsigned)((s0 + 8 * (n >> 2) + (n & 3)) * 144 + 16 * q), wvl = (unsigned)(n * 144 + (s0 + 8 * q) * 2);
    LAS const float* rpl = (LAS const float*)(lds + ATT_RP) + (s0 + 8 * q - qc + 31);
    const unsigned stg_k = (unsigned)(((tid >> 3) * ZP + 8 * (tid & 7)) * 2), stg_v = (unsigned)(((tid >> 3) * VT_LD + 8 * (tid & 7)) * 2);
    const unsigned stg_l = (unsigned)((tid >> 3) * 144 + (tid & 7) * 16);
#pragma unroll 1
    for (int pass = 0; pass < 2; ++pass) {
        const int r_first = 16 * jj + 8 * pass, KR0 = min(max(r_first - 4, 0), 120), nrows = min(max(r_first + 7 - 4, 0), 120) + 8 - KR0;
        bf16x8 qf[4][2]; f32x4 o[4][4]; float mrun[4], lrun[4]; int rbu[4];
#pragma unroll
        for (int u = 0; u < 4; ++u) { const int r = r_first + par + 2 * u; rbu[u] = min(max(r - 4, 0), 120);
            const int qso = ((b * SEQ + r * 64 + a) * ZP + Q_OFF + h * 64) * 2;
            qf[u][0] = bld128(rsZ, qlane, qso); qf[u][1] = bld128(rsZ, qlane, qso + 64); mrun[u] = -INFINITY; lrun[u] = 0.f;
#pragma unroll
            for (int dt = 0; dt < 4; ++dt) o[u][dt] = (f32x4){0.f, 0.f, 0.f, 0.f}; }
        const int kg0 = ((b * SEQ + KR0 * 64) * ZP + K_OFF + h * 64) * 2, vg0 = (bh * 64 * VT_LD + KR0 * 64) * 2;
        bf16x8 ka, va, kb_, vb_;
        ka = bld128(rsZ, stg_k, kg0); va = bld128(rsV, stg_v, vg0);
        kb_ = bld128(rsZ, stg_k, kg0 + 64 * ZP * 2); vb_ = bld128(rsV, stg_v, vg0 + 64 * 2);
        *(LAS bf16x8*)(lds + ATT_WK + stg_l) = ka; *(LAS bf16x8*)(lds + ATT_WV + stg_l) = va;
        __syncthreads();
#define ATT_ROW(kk_, slot_, RK, RV, NK, NV) do { const int kk = (kk_); \
            if (kk + 2 < nrows) { NK = bld128(rsZ, stg_k, kg0 + (kk + 2) * (64 * ZP * 2)); NV = bld128(rsV, stg_v, vg0 + (kk + 2) * (64 * 2)); } \
            { bf16x8 kf[4], vf[4]; LAS const unsigned char* kp = lds + ATT_WK + (slot_) * 9216 + wkl; LAS const unsigned char* vp = lds + ATT_WV + (slot_) * 9216 + wvl; \
              kf[0] = *(const LAS bf16x8*)kp; kf[1] = *(const LAS bf16x8*)(kp + 64); kf[2] = *(const LAS bf16x8*)(kp + 4 * 144); kf[3] = *(const LAS bf16x8*)(kp + 4 * 144 + 64); \
              _Pragma("unroll") for (int dt = 0; dt < 4; ++dt) vf[dt] = *(const LAS bf16x8*)(vp + dt * (16 * 144)); \
              _Pragma("unroll") for (int u = 0; u < 4; ++u) { const int krow = KR0 + kk; \
                  if (krow >= rbu[u] && krow < rbu[u] + 8) att_step<true>(kf, vf, qf[u], o[u], mrun[u], lrun[u], rpl + 64 * (krow - (r_first + par + 2 * u) + 7), mk); } } \
            if (kk + 1 < nrows) { *(LAS bf16x8*)(lds + ATT_WK + (1 - (slot_)) * 9216 + stg_l) = RK; *(LAS bf16x8*)(lds + ATT_WV + (1 - (slot_)) * 9216 + stg_l) = RV; } \
            __syncthreads(); } while (0)
#pragma unroll 1
        for (int k2 = 0; k2 < nrows; k2 += 2) {
            ATT_ROW(k2, 0, kb_, vb_, ka, va);
            if (k2 + 1 < nrows) ATT_ROW(k2 + 1, 1, ka, va, kb_, vb_);
        }
#undef ATT_ROW
        att_ctx<4>(lds, qf, o, mrun, lrun, mk, n, q);
#pragma unroll
        for (int u = 0; u < 4; ++u) { float lt = lrun[u]; lt = quad_sum(lt); const float inv = 1.0f / lt;
            const int qso = ((b * SEQ + (r_first + par + 2 * u) * 64 + a) * ZP + Q_OFF + h * 64) * 2;
#pragma unroll
            for (int dt = 0; dt < 4; ++dt) { u32x2 w; w.x = pk2(o[u][dt][0] * inv, o[u][dt][1] * inv); w.y = pk2(o[u][dt][2] * inv, o[u][dt][3] * inv);
                if (DUMMY) *(u32x2*)(dummy + ((size_t)(vcu * 8 + wave) * 16 + n) * 64 + 16 * dt + 4 * q) = w; else __builtin_amdgcn_raw_buffer_store_b64(w, rsZ, (int)olane, qso + 32 * dt, 0); } }
    }
    if (do_ctx_queries && wave < 2) {
        bf16x8 qf[4][2]; f32x4 o[4][4]; float mrun[4], lrun[4];
        const int qso = ((ML + b * CTXL + 16 * (2 * jj + wave)) * ZP + Q_OFF + h * 64) * 2;
        qf[0][0] = bld128(rsZ, qlane, qso); qf[0][1] = bld128(rsZ, qlane, qso + 64); mrun[0] = -INFINITY; lrun[0] = 0.f;
#pragma unroll
        for (int dt = 0; dt < 4; ++dt) o[0][dt] = (f32x4){0.f, 0.f, 0.f, 0.f};
        att_ctx<1>(lds, qf, o, mrun, lrun, mk, n, q);
        float lt = lrun[0]; lt = quad_sum(lt); const float inv = 1.0f / lt;
#pragma unroll
        for (int dt = 0; dt < 4; ++dt) { u32x2 w; w.x = pk2(o[0][dt][0] * inv, o[0][dt][1] * inv); w.y = pk2(o[0][dt][2] * inv, o[0][dt][3] * inv);
            if (DUMMY) *(u32x2*)(dummy + ((size_t)(vcu * 8 + wave) * 16 + n) * 64 + 16 * dt + 4 * q) = w; else __builtin_amdgcn_raw_buffer_store_b64(w, rsZ, (int)olane, qso + 32 * dt, 0); }
    }
}

__device__ __forceinline__ void f1_unit(const bf16* Z, bf16* R, LAS const unsigned char* T64, LAS const unsigned char* TA, int b_, int g_, int l2_, int cb_, int lane) {
    const int b = RFL(b_), g = RFL(g_), l2 = RFL(l2_), cb = RFL(cb_);
    const int n = lane & 15, q = lane >> 4;
    const char* ubase = (const char*)(Z + (size_t)(b * SEQ + l2) * ZP + g * 64); const unsigned ulane = (unsigned)(n * 64 * ZP + 8 * q) * 2u;
    f32x4 pr[8], pi[8];
#pragma unroll
    for (int mt = 0; mt < 8; ++mt) { pr[mt] = (f32x4){0.f, 0.f, 0.f, 0.f}; pi[mt] = (f32x4){0.f, 0.f, 0.f, 0.f}; }
#pragma unroll
    for (int ks = 0; ks < 2; ++ks) {
        const bf16x8 bre = *(const LAS bf16x8*)(T64 + ((0 * 64 + 16 * cb + n) * 64 + 32 * ks + 8 * q) * 2);
        const bf16x8 bim = *(const LAS bf16x8*)(T64 + ((1 * 64 + 16 * cb + n) * 64 + 32 * ks + 8 * q) * 2);
#pragma unroll
        for (int mt = 0; mt < 8; ++mt) {
            const bf16x8 av = ldg_u<bf16x8>(ubase + ((size_t)(16 * mt * 64) * ZP + 32 * ks) * 2, ulane);
            pr[mt] = MFMA16(av, bre, pr[mt]); pi[mt] = MFMA16(av, bim, pi[mt]); }
        __builtin_amdgcn_sched_barrier(0);
    }
    bf16x8 fr[4], fi[4], fn[4];
#pragma unroll
    for (int k2 = 0; k2 < 4; ++k2) {
        u32x4 wr_, wi_, wn_;
        wr_.x = pk2(pr[2 * k2][0], pr[2 * k2][1]); wr_.y = pk2(pr[2 * k2][2], pr[2 * k2][3]); wr_.z = pk2(pr[2 * k2 + 1][0], pr[2 * k2 + 1][1]); wr_.w = pk2(pr[2 * k2 + 1][2], pr[2 * k2 + 1][3]);
        wi_.x = pk2(pi[2 * k2][0], pi[2 * k2][1]); wi_.y = pk2(pi[2 * k2][2], pi[2 * k2][3]); wi_.z = pk2(pi[2 * k2 + 1][0], pi[2 * k2 + 1][1]); wi_.w = pk2(pi[2 * k2 + 1][2], pi[2 * k2 + 1][3]);
        wn_ = wr_ ^ 0x80008000u;
        fr[k2] = __builtin_bit_cast(bf16x8, wr_); fi[k2] = __builtin_bit_cast(bf16x8, wi_); fn[k2] = __builtin_bit_cast(bf16x8, wn_);
    }
    char* rbase = (char*)(R + (size_t)(b * 4 + g) * 128 * 64 * 128 + (size_t)l2 * 128 + 16 * cb); const unsigned rlane = (unsigned)(4 * q * 64 * 128 + n) * 2u;
#pragma unroll
    for (int mt = 0; mt < 8; ++mt) {
        f32x4 qr = (f32x4){0.f, 0.f, 0.f, 0.f}, qi = (f32x4){0.f, 0.f, 0.f, 0.f};
#pragma unroll
        for (int k2 = 0; k2 < 4; ++k2) {
            const bf16x8 ac = *(const LAS bf16x8*)(TA + (((0 * 8 + mt) * 4 + k2) * 64 + lane) * 16);
            const bf16x8 as = *(const LAS bf16x8*)(TA + (((1 * 8 + mt) * 4 + k2) * 64 + lane) * 16);
            qr = MFMA16(ac, fr[k2], qr); qr = MFMA16(as, fi[k2], qr); qi = MFMA16(ac, fi[k2], qi); qi = MFMA16(as, fn[k2], qi);
        }
#pragma unroll
        for (int j = 0; j < 4; ++j) { const int k1 = 16 * mt + 4 * q + j; const float ang = (float)((l2 * k1) & 8191) * (1.0f / 4096.0f);
            const float ct = cospif(ang), st = sinpif(ang);
            const float rr = qr[j] * ct + qi[j] * st, ri = qi[j] * ct - qr[j] * st;
            char* p = rbase + (size_t)((16 * mt + j) * 64 * 128) * 2;
            *(bf16*)(p + rlane) = (bf16)(pk2(rr, 0.f) & 0xffffu); *(bf16*)(p + 128 + rlane) = (bf16)(pk2(ri, 0.f) & 0xffffu); }
        __builtin_amdgcn_sched_barrier(0);
    }
}
__device__ __forceinline__ void f3_unit(const bf16* R, bf16* Z, LAS const unsigned char* T3F, LAS unsigned char* scr, int b, int g, int k1, int ch, int lane) {
    const int n = lane & 15, q = lane >> 4;
    const bf16* Rb = R + ((size_t)((b * 4 + g) * 128 + k1) * 64) * 128;
#pragma unroll
    for (int i = 0; i < 8; ++i) { const int p = lane + 64 * i, l2 = p >> 3, reim = (p >> 2) & 1, piece = p & 3;
        const u32x4 v = *(const u32x4*)(Rb + (l2 * 2 + reim) * 64 + 32 * ch + 8 * piece);
        *(LAS u32x4*)(scr + l2 * 144 + reim * 64 + piece * 16) = v; }
    LDS_WAIT(); asm volatile("" ::: "memory");
    bf16x8 bfr[2][4];
#pragma unroll
    for (int nt = 0; nt < 2; ++nt)
#pragma unroll
        for (int ks = 0; ks < 4; ++ks) { u32x4 w; unsigned e[8];
#pragma unroll
            for (int j = 0; j < 8; ++j) { const int l2 = 32 * (ks & 1) + 8 * q + j; e[j] = *(const LAS unsigned short*)(scr + l2 * 144 + (ks >> 1) * 64 + (16 * nt + n) * 2); }
            w.x = e[0] | (e[1] << 16); w.y = e[2] | (e[3] << 16); w.z = e[4] | (e[5] << 16); w.w = e[6] | (e[7] << 16);
            bfr[nt][ks] = __builtin_bit_cast(bf16x8, w); }
    const float sc = 0.00138106793f;
#pragma unroll
    for (int mt = 0; mt < 4; ++mt) {
        f32x4 y0 = (f32x4){0.f, 0.f, 0.f, 0.f}, y1 = (f32x4){0.f, 0.f, 0.f, 0.f};
#pragma unroll
        for (int ks = 0; ks < 4; ++ks) { const bf16x8 av = *(const LAS bf16x8*)(T3F + ((mt * 4 + ks) * 64 + lane) * 16);
            y0 = MFMA16(av, bfr[0][ks], y0); y1 = MFMA16(av, bfr[1][ks], y1); }
#pragma unroll
        for (int j = 0; j < 4; ++j) { const int k2 = 16 * mt + 4 * q + j; bf16* p = Z + (size_t)(b * SEQ + k1 + 128 * k2) * ZP + g * 64 + 32 * ch + n;
            p[0] = (bf16)(pk2(y0[j] * sc, 0.f) & 0xffffu); p[16] = (bf16)(pk2(y1[j] * sc, 0.f) & 0xffffu); }
    }
    LDS_WAIT(); asm volatile("" ::: "memory");
}

__device__ __forceinline__ void stagger(unsigned ticks) {
    const unsigned dl = ((blockIdx.x >> 3) & 7u) * ticks; const unsigned long long t0 = __builtin_amdgcn_s_memrealtime();
    while ((unsigned)(__builtin_amdgcn_s_memrealtime() - t0) < dl) __builtin_amdgcn_s_sleep(4);
}
#ifndef STAG_INPROJ
#define STAG_INPROJ 0
#endif
struct Args { const float* in[23]; float* out; unsigned char* ws; };
__device__ __forceinline__ unsigned long long pt_get(LAS const unsigned long long* PT, int i) {
    int off = i; asm volatile("" : "+v"(off));
    const unsigned long long v = PT[off];
    const unsigned lo = __builtin_amdgcn_readfirstlane((unsigned)v), hi = __builtin_amdgcn_readfirstlane((unsigned)(v >> 32));
    return ((unsigned long long)hi << 32) | lo;
}
#define INP(i) ((const float*)(const GAS float*)pt_get(PT, (i)))
#define OUTP ((float*)(GAS float*)pt_get(PT, 23))
#define WSP(off) ((unsigned char*)(GAS unsigned char*)(pt_get(PT, 24) + (unsigned long long)(off)))

#define PHASE_IDS() const int tid = fresh_tid(), lane = tid & 63, wave = __builtin_amdgcn_readfirstlane(tid >> 6); const int G = fresh_s((int)gridDim.x), bx = fresh_s((int)blockIdx.x); \
    const int vcu = (G % 8 == 0) ? (bx % 8) * (G / 8) + bx / 8 : bx; const int gw = vcu * NWAVES + wave, NGW = G * NWAVES; (void)tid; (void)lane; (void)wave; (void)vcu; (void)gw; (void)NGW; (void)bx
__global__ void __launch_bounds__(NWAVES * 64, 2) fwd_kernel(Args args) {
    extern __shared__ __attribute__((aligned(16))) unsigned char lds_raw[];
    LAS unsigned char* lds = (LAS unsigned char*)lds_raw;
    volatile LAS unsigned* MISC = (volatile LAS unsigned*)(lds + MISC_OFF);
    LAS unsigned long long* PT = (LAS unsigned long long*)(lds + LDSCTL_OFF + 512);
    { const int tid = threadIdx.x;

    for (int u = tid; u < (LDS_BYTES - LDSCTL_OFF) / 4; u += NWAVES * 64) ((LAS unsigned*)(lds + LDSCTL_OFF))[u] = 0u;
    __syncthreads();
    if (tid < 23) PT[tid] = (unsigned long long)args.in[tid];
    if (tid == 23) PT[23] = (unsigned long long)args.out;
    if (tid == 24) PT[24] = (unsigned long long)args.ws;
    __syncthreads();
    }
    XcdBarrier bar = xcd_barrier_post((unsigned*)WSP(WS_CTL) + CW_BAR, MISC + 8);
#define GRID_BAR() xcd_barrier(bar)
#ifdef PROBE_GA
    LAS unsigned* TSW = (LAS unsigned*)(lds + LDSCTL_OFF + 2048);
    if (blockIdx.x == 0 && threadIdx.x == 0) TSW[32] = (unsigned)wall_clock64();
#define STAMP(g) do { if (blockIdx.x == 0 && threadIdx.x == 0) { const unsigned t_ = (unsigned)wall_clock64(); TSW[(g)] += t_ - TSW[32]; TSW[32] = t_; } } while (0)
#else
#define STAMP(g) do { } while (0)
#endif

    {
            PHASE_IDS();
        if (vcu < 192) {
            LAS float* S = (LAS float*)lds;
            LAS float* P = (LAS float*)(lds + 32768);
            { const float* c_in = INP(1); const float* cctx_in = INP(3);
              for (int i = tid; i < 5 * D; i += NWAVES * 64) { const int v = i >> 10, k = i & 1023; const float cv = v < 4 ? c_in[v * D + k] : cctx_in[k]; S[i] = cv / (1.0f + __expf(-cv)); } }
            __syncthreads();
            const int l = vcu / 96, j = (vcu % 96) * 64 + lane;
            const float* W = INP(6) + (size_t)l * D * NMOD + j;
            float a0 = 0.f, a1 = 0.f, a2 = 0.f, a3 = 0.f, a4 = 0.f;
#pragma unroll 32
            for (int kk = 0; kk < 128; ++kk) { const int k = wave * 128 + kk; const float w = W[(size_t)k * NMOD];
                a0 += S[k] * w; a1 += S[D + k] * w; a2 += S[2 * D + k] * w; a3 += S[3 * D + k] * w; a4 += S[4 * D + k] * w; }
            P[(wave * 5 + 0) * 64 + lane] = a0; P[(wave * 5 + 1) * 64 + lane] = a1; P[(wave * 5 + 2) * 64 + lane] = a2; P[(wave * 5 + 3) * 64 + lane] = a3; P[(wave * 5 + 4) * 64 + lane] = a4;
            __syncthreads();
            if (wave < 5) { float s = INP(7)[l * NMOD + j];
#pragma unroll
                for (int w8 = 0; w8 < 8; ++w8) s += P[(w8 * 5 + wave) * 64 + lane];
                ((float*)WSP(WS_MOD))[((size_t)l * 5 + wave) * NMOD + j] = s; }
        }
        { bf16* TB = (bf16*)WSP(WS_TAB);
          for (int i = vcu * 512 + tid; i < 49152; i += G * 512) { float v;
              if (i < 8192) { const int reim = i >> 12, cp = (i >> 6) & 63, c = i & 63; const float ang = (float)((c * cp) & 63) * (1.0f / 32.0f); v = reim ? -sinpif(ang) : cospif(ang); }
              else if (i < 40960) { const int ii = i - 8192, e = ii & 7, ln = (ii >> 3) & 63, k2 = (ii >> 9) & 3, mt = (ii >> 11) & 7, cs = ii >> 14;
                  const int k1 = 16 * mt + (ln & 15), qq = ln >> 4, l1 = 32 * k2 + (e < 4 ? 4 * qq + e : 16 + 4 * qq + (e - 4));
                  const float ang = (float)((k1 * l1) & 127) * (1.0f / 64.0f); v = cs ? sinpif(ang) : cospif(ang); }
              else { const int ii = i - 40960, e = ii & 7, ln = (ii >> 3) & 63, ks = (ii >> 9) & 3, mt = ii >> 11;
                  const int k2 = 16 * mt + (ln & 15), kap = 32 * ks + 8 * (ln >> 4) + e, l2 = kap & 63;
                  const float ang = (float)((k2 * l2) & 63) * (1.0f / 32.0f); v = (kap >= 64) ? sinpif(ang) : cospif(ang); }
              TB[i] = (bf16)(pk2(v, 0.f) & 0xffffu); } }
        __syncthreads();
        LAS float* scr = (LAS float*)(lds + wave * 16384);
        int base = 0;
#pragma unroll 1
        for (int l = 0; l < 2; ++l) {
            tr_matrix(INP(8) + (size_t)l * D * PW, D, PW, (bf16*)WSP(WS_WIN) + (size_t)l * PW * D, D, 0, 0, base, gw, NGW, scr, lane);
            tr_matrix(INP(11) + (size_t)l * 256 * D, 256, D, (bf16*)WSP(WS_WCAT) + (size_t)l * D * D, D, 0, 0, base, gw, NGW, scr, lane);
            tr_matrix(INP(12) + (size_t)l * 512 * D, 512, D, (bf16*)WSP(WS_WCAT) + (size_t)l * D * D, D, 256, 0, base, gw, NGW, scr, lane);
            tr_matrix(INP(13) + (size_t)l * 256 * D, 256, D, (bf16*)WSP(WS_WCAT) + (size_t)l * D * D, D, 768, 0, base, gw, NGW, scr, lane);
            tr_matrix(INP(14) + (size_t)l * D * D, D, D, (bf16*)WSP(WS_WOUT) + (size_t)l * D * D, D, 0, 0, base, gw, NGW, scr, lane);
        }
        tr_matrix(INP(15), D, DFF, (bf16*)WSP(WS_WGU0), D, 0, 1, base, gw, NGW, scr, lane);
        tr_matrix(INP(16), D, DFF, (bf16*)WSP(WS_WGU0), D, 0, 2, base, gw, NGW, scr, lane);
        tr_matrix(INP(17), DFF, D, (bf16*)WSP(WS_WD0), DFF, 0, 0, base, gw, NGW, scr, lane);
    }
    GRID_BAR(); STAMP(0);

#pragma unroll 1
    for (int l = 0; l < 2; ++l) {
        const int Mmix = (l == 0) ? MT : ML;

        {
            PHASE_IDS();
            LAS float* TA_ = (LAS float*)lds; LAS float* TS_ = (LAS float*)(lds + 20480);
            norm_tables(TA_, TS_, INP(4) + l * D, (const float*)WSP(WS_MOD) + (size_t)l * 5 * NMOD, 0, D, tid);
            __syncthreads();
            bf16* HX = (bf16*)WSP(WS_HX);
            const float* xl_cur = (l == 0) ? INP(0) : (const float*)OUTP; const float* xc_cur = (l == 0) ? INP(2) : (const float*)WSP(WS_XC);
            norm_phase_rows(xl_cur, xc_cur, ML, TA_, TS_, HX, gw, NGW, lane);
            if (l == 0) norm_ctx_rows<0, 0>(INP(2), nullptr, nullptr, TA_, TS_, HX, gw, NGW, lane);
            else norm_ctx_rows<4, 11>(INP(2), (const float*)WSP(WS_R), (const float*)WSP(WS_PART), TA_, TS_, HX, gw, NGW, lane);
        }
        GRID_BAR(); STAMP(1);

        { pg8::Gemm g{D, D}; pg8::SchedPlain S; S.init(MT, PW, D, (const bf16*)WSP(WS_HX), D, (const bf16*)WSP(WS_WIN) + (size_t)l * PW * D, D, fresh_s((int)gridDim.x), fresh_s((int)blockIdx.x));
          pg8::EpiInProj E{(bf16*)WSP(WS_Z), (bf16*)WSP(WS_VT), (unsigned char*)WSP(WS_GQ)};
          if (STAG_INPROJ) stagger(STAG_INPROJ);
          pg8::gemm_phase<pg8::EpiInProj, pg8::SchedPlain>(lds, g, S, E);
        }
        GRID_BAR(); STAMP(2);

        {
            PHASE_IDS();
            LAS unsigned char* T64 = lds;
            LAS unsigned char* TA = lds + 16384;
            LAS float* C64 = (LAS float*)(lds + 120832);
            LAS float* CW = (LAS float*)(lds + 120832 + 512);
            { const u32x4* TB = (const u32x4*)WSP(WS_TAB);
#pragma unroll
              for (int i = 0; i < 10; ++i) *(LAS u32x4*)(lds + (tid + 512 * i) * 16) = TB[tid + 512 * i]; }
            if (tid < 64) { const float ang = (float)tid * (1.0f / 32.0f); C64[tid] = cospif(ang); C64[64 + tid] = sinpif(ang); }
            { const float* cw = INP(9) + l * 768; for (int i = tid; i < 768; i += NWAVES * 64) CW[i] = cw[i]; }
            __syncthreads();
            bf16* Z = (bf16*)WSP(WS_Z);
            { bf16* RB = (bf16*)WSP(WS_R);
              _Pragma("unroll 1") for (int uid = gw; uid < 4096; uid += NGW) f1_unit(Z, RB, T64, TA, uid >> 10, (uid >> 8) & 3, (uid >> 2) & 63, uid & 3, lane); }
            if (l == 0) { unsigned* CP = (unsigned*)WSP(WS_CP);
              for (int it = vcu * 512 + tid; it < MC * 256; it += G * 512) { const int cp = it & 63, gg = (it >> 6) & 3, tok = it >> 8;
                const bf16* up = Z + (size_t)(ML + tok) * ZP + gg * 64; float pr = 0.f, pi = 0.f;
#pragma unroll
                for (int c8 = 0; c8 < 8; ++c8) { const u32x4 w = *(const u32x4*)(up + 8 * c8); const float uv[8] = {bflo(w.x), bfhi(w.x), bflo(w.y), bfhi(w.y), bflo(w.z), bfhi(w.z), bflo(w.w), bfhi(w.w)};
#pragma unroll
                    for (int j = 0; j < 8; ++j) { const int idx = ((8 * c8 + j) * cp) & 63; pr += uv[j] * C64[idx]; pi -= uv[j] * C64[64 + idx]; } }
                CP[(((size_t)((tok >> 8) * 4 + gg) * 256 + (tok & 255)) * 64 + cp)] = pk2(pr, pi); } }
            for (int it = vcu * 512 + tid; it < Mmix * 32; it += G * 512) { const int row = it >> 5, ch = (it & 31) * 8;
                const bool lat = row < ML; const int pos = lat ? (row & 8191) : ((row - ML) & 255), len = lat ? SEQ : CTXL;
                bf16* zr = Z + (size_t)row * ZP; float p[3][8];
#pragma unroll
                for (int d = 0; d < 3; ++d) { const bool ok = (d == 1) || (d == 0 ? pos > 0 : pos < len - 1);
                    if (ok) { const bf16* rr = zr + (ptrdiff_t)(d - 1) * ZP; const u32x4 wu = *(const u32x4*)(rr + U_OFF + ch), wc = *(const u32x4*)(rr + C_OFF + ch);
                        p[d][0] = bflo(wu.x) * bflo(wc.x); p[d][1] = bfhi(wu.x) * bfhi(wc.x); p[d][2] = bflo(wu.y) * bflo(wc.y); p[d][3] = bfhi(wu.y) * bfhi(wc.y);
                        p[d][4] = bflo(wu.z) * bflo(wc.z); p[d][5] = bfhi(wu.z) * bfhi(wc.z); p[d][6] = bflo(wu.w) * bflo(wc.w); p[d][7] = bfhi(wu.w) * bfhi(wc.w); }
                    else {
#pragma unroll
                        for (int j = 0; j < 8; ++j) p[d][j] = 0.f; } }
                const u32x4 wb = *(const u32x4*)(zr + B_OFF + ch); const float zb[8] = {bflo(wb.x), bfhi(wb.x), bflo(wb.y), bfhi(wb.y), bflo(wb.z), bfhi(wb.z), bflo(wb.w), bfhi(wb.w)};
                float o[8];
#pragma unroll
                for (int j = 0; j < 8; ++j) o[j] = zb[j] * (CW[ch + j] * p[0][j] + CW[256 + ch + j] * p[1][j] + CW[512 + ch + j] * p[2][j]);
                u32x4 w; w.x = pk2(o[0], o[1]); w.y = pk2(o[2], o[3]); w.z = pk2(o[4], o[5]); w.w = pk2(o[6], o[7]);
                *(u32x4*)(zr + B_OFF + ch) = w; }
        }
        GRID_BAR(); STAMP(3);

        {
            PHASE_IDS();
            LAS unsigned char* T3F = lds;
            LAS float* C256 = (LAS float*)(lds + 16384);
            LAS unsigned char* scr = lds + 32768 + wave * 9216;
            { const u32x4* TB = (const u32x4*)(WSP(WS_TAB) + 81920);
#pragma unroll
              for (int i = 0; i < 2; ++i) *(LAS u32x4*)(lds + (tid + 512 * i) * 16) = TB[tid + 512 * i]; }
            if (tid < 256) { const float ang = (float)tid * (1.0f / 128.0f); C256[tid] = cospif(ang); C256[256 + tid] = sinpif(ang); }
            __syncthreads();
            bf16* Z = (bf16*)WSP(WS_Z);
            { const bf16* RB = (const bf16*)WSP(WS_R);
              _Pragma("unroll 1") for (int uid = gw; uid < 4096; uid += NGW) f3_unit(RB, Z, T3F, scr, uid >> 10, (uid >> 8) & 3, (uid >> 1) & 127, uid & 1, lane); }
            if (l == 0) { __syncthreads();
                LAS unsigned* PS = (LAS unsigned*)(lds + 32768);
                const int b = vcu >> 6, gg = (vcu >> 4) & 3, lp0 = (vcu & 15) * 16;
                const unsigned* CPs = (const unsigned*)WSP(WS_CP) + (size_t)(b * 4 + gg) * 256 * 64;
#pragma unroll
                for (int i = 0; i < 8; ++i) *(LAS u32x4*)(PS + (tid + 512 * i) * 4) = *(const u32x4*)(CPs + (tid + 512 * i) * 4);
                __syncthreads();
                const int cp = tid & 63, lpa = lp0 + (tid >> 6), lpb = lpa + 8; float ya = 0.f, yb = 0.f;
#pragma unroll 8
                for (int li = 0; li < CTXL; ++li) { const unsigned w = PS[li * 64 + cp]; const float pr = bflo(w), pi = bfhi(w); const int ia = (li * lpa) & 255, ib = (li * lpb) & 255;
                    ya += C256[ia] * pr + C256[256 + ia] * pi; yb += C256[ib] * pr + C256[256 + ib] * pi; }
                Z[(size_t)(ML + b * CTXL + lpa) * ZP + gg * 64 + cp] = (bf16)(pk2(ya * (1.0f / 128.0f), 0.f) & 0xffffu);
                Z[(size_t)(ML + b * CTXL + lpb) * ZP + gg * 64 + cp] = (bf16)(pk2(yb * (1.0f / 128.0f), 0.f) & 0xffffu); }
            __syncthreads();
            attn_phase(lds, Z, (const bf16*)WSP(WS_VT), INP(10) + (size_t)l * 8 * 465, l == 0, vcu, tid);
        }
        GRID_BAR(); STAMP(4);

        { pg8::Gemm g{ZP, D}; pg8::SchedMerge S{Mmix / 256, fresh_s((int)gridDim.x), fresh_s((int)blockIdx.x), (const char*)WSP(WS_Z), (const char*)((const bf16*)WSP(WS_WCAT) + (size_t)l * D * D)};
          pg8::EpiMerge E{(const unsigned char*)WSP(WS_GQ), (bf16*)WSP(WS_HX)};
          pg8::gemm_phase<pg8::EpiMerge, pg8::SchedMerge>(lds, g, S, E);
        }
        GRID_BAR(); STAMP(5);

        { pg8::Gemm g{D, D}; pg8::SchedSplitCtx S{fresh_s((int)gridDim.x), fresh_s((int)blockIdx.x), D / 64, l == 0 ? 1 : 0, (const char*)WSP(WS_HX), (const char*)((const bf16*)WSP(WS_WOUT) + (size_t)l * D * D), (size_t)256 * D * 2, (size_t)256 * D * 2};
          pg8::EpiResid E{(l == 0) ? INP(0) : (const float*)OUTP, nullptr, OUTP, nullptr, (const float*)WSP(WS_MOD) + (size_t)l * 5 * NMOD + 2 * D, (float*)WSP(WS_R)};
          pg8::gemm_phase<pg8::EpiResid, pg8::SchedSplitCtx>(lds, g, S, E);
        }
        GRID_BAR(); STAMP(6);

        if (l == 0) {
            {
            PHASE_IDS();
                LAS float* TA_ = (LAS float*)lds; LAS float* TS_ = (LAS float*)(lds + 20480);
                norm_tables(TA_, TS_, INP(5), (const float*)WSP(WS_MOD), 3 * D, 4 * D, tid);
                __syncthreads();
                bf16* HX = (bf16*)WSP(WS_HX); const float* xl = OUTP; const float* xc = (const float*)WSP(WS_XC);
                norm_phase_rows(xl, xc, ML, TA_, TS_, HX, gw, NGW, lane);
                norm_ctx_rows<4, 0>(INP(2), (const float*)WSP(WS_R), nullptr, TA_, TS_, HX, gw, NGW, lane);
            }
            GRID_BAR(); STAMP(1);
            { pg8::Gemm g{D, D}; pg8::SchedPlain S; S.init(MT, 2 * DFF, D, (const bf16*)WSP(WS_HX), D, (const bf16*)WSP(WS_WGU0), D, fresh_s((int)gridDim.x), fresh_s((int)blockIdx.x));
              pg8::EpiSwiglu E{(bf16*)WSP(WS_G), DFF};
              pg8::gemm_phase<pg8::EpiSwiglu, pg8::SchedPlain>(lds, g, S, E);
            }
            GRID_BAR(); STAMP(7);
            { pg8::Gemm g{DFF, DFF}; pg8::SchedSplitCtx S{fresh_s((int)gridDim.x), fresh_s((int)blockIdx.x), DFF / 64, 1, (const char*)WSP(WS_G), (const char*)WSP(WS_WD0), (size_t)256 * DFF * 2, (size_t)256 * DFF * 2};
              pg8::EpiResid E{OUTP, nullptr, OUTP, nullptr, (const float*)WSP(WS_MOD) + 5 * D, (float*)WSP(WS_PART)};
              pg8::gemm_phase<pg8::EpiResid, pg8::SchedSplitCtx>(lds, g, S, E); }
            GRID_BAR(); STAMP(8);
        } else {
            {
            PHASE_IDS();
                LAS float* WR = (LAS float*)lds;
                LAS int* LC = (LAS int*)(lds + 32768);
                LAS unsigned* RT = (LAS unsigned*)(lds + 32768 + 64);
                { const float* wr = INP(18); for (int i = tid; i < D * NE; i += NWAVES * 64) WR[i] = wr[i]; }
                if (tid < 16) LC[tid] = 0;
                __syncthreads();
                const int rpw = ML / (G * NWAVES);
                {
                LAS float* TA_ = (LAS float*)(lds + 40960); LAS float* TS_ = (LAS float*)(lds + 61440);
                norm_tables(TA_, TS_, INP(5) + D, (const float*)WSP(WS_MOD) + (size_t)5 * NMOD, 3 * D, 4 * D, tid);
                __syncthreads();
                bf16* HX = (bf16*)WSP(WS_HX); const float* xl = OUTP;
#pragma unroll 1
                for (int i = 0; i < rpw; i += 2) { const int rl = wave * rpw + i, row = vcu * (rpw * NWAVES) + rl, v = row >> 13;
                    f32x4 hv[2][4]; norm_rows2(xl + (size_t)row * D, xl + (size_t)(row + 1) * D, TA_ + v * D, TS_ + v * D, TA_ + v * D, TS_ + v * D, HX + (size_t)row * D, HX + (size_t)(row + 1) * D, true, lane, hv[0], hv[1]);
                    float lg[2][NE];
#pragma unroll
                    for (int e = 0; e < NE; ++e) { lg[0][e] = 0.f; lg[1][e] = 0.f; }
#pragma unroll
                    for (int j = 0; j < 4; ++j)
#pragma unroll
                        for (int cc = 0; cc < 4; ++cc) { const int k = 4 * lane + 256 * j + cc; const f32x4 w0 = *(const LAS f32x4*)(WR + k * 8), w1 = *(const LAS f32x4*)(WR + k * 8 + 4);
#pragma unroll
                            for (int t = 0; t < 2; ++t) { const float hvv = hv[t][j][cc];
                                lg[t][0] += hvv * w0.x; lg[t][1] += hvv * w0.y; lg[t][2] += hvv * w0.z; lg[t][3] += hvv * w0.w; lg[t][4] += hvv * w1.x; lg[t][5] += hvv * w1.y; lg[t][6] += hvv * w1.z; lg[t][7] += hvv * w1.w; } }
#pragma unroll
                    for (int o = 1; o < 64; o <<= 1)
#pragma unroll
                        for (int e = 0; e < NE; ++e) { lg[0][e] += shx(lg[0][e], o, lane); lg[1][e] += shx(lg[1][e], o, lane); }
#pragma unroll
                    for (int t = 0; t < 2; ++t) {
                        int e0 = 0; float v0 = lg[t][0];
#pragma unroll
                        for (int e = 1; e < NE; ++e) if (lg[t][e] > v0) { v0 = lg[t][e]; e0 = e; }
                        int e1 = -1; float v1 = -INFINITY;
#pragma unroll
                        for (int e = 0; e < NE; ++e) if (e != e0 && lg[t][e] > v1) { v1 = lg[t][e]; e1 = e; }
                        const float w1 = 1.0f / (1.0f + __expf(v0 - v1)), w0 = 1.0f - w1;
                        if (lane == 0) { const int s0 = __hip_atomic_fetch_add(LC + e0, 1, __ATOMIC_RELAXED, __HIP_MEMORY_SCOPE_WORKGROUP), s1 = __hip_atomic_fetch_add(LC + e1, 1, __ATOMIC_RELAXED, __HIP_MEMORY_SCOPE_WORKGROUP);
                            LAS unsigned* rt = RT + (rl + t) * 6; rt[0] = (unsigned)e0; rt[1] = (unsigned)s0; rt[2] = (unsigned)e1; rt[3] = (unsigned)s1; rt[4] = __float_as_uint(w0); rt[5] = __float_as_uint(w1); } }
                }
                }
                __syncthreads();
                if (tid < NE) LC[8 + tid] = (int)xb_add((unsigned*)WSP(WS_CTL) + CW_CNT + 64 * tid, (unsigned)LC[tid]);
                __syncthreads();
                if (tid < rpw * NWAVES) { const int row = vcu * (rpw * NWAVES) + tid; const unsigned e0 = RT[tid * 6], e1 = RT[tid * 6 + 2];
                    u32x4 r; r.x = e0 | ((unsigned)(LC[8 + e0] + (int)RT[tid * 6 + 1]) << 8); r.y = e1 | ((unsigned)(LC[8 + e1] + (int)RT[tid * 6 + 3]) << 8); r.z = RT[tid * 6 + 4]; r.w = RT[tid * 6 + 5];
                    ((u32x4*)WSP(WS_ROUTE))[row] = r; }
                __syncthreads();
                LAS float* scr = (LAS float*)(lds + wave * 16384);
                int base = 0;
#pragma unroll 1
                for (int e = 0; e < NE; ++e) {
                    tr_matrix(INP(19) + (size_t)e * D * DFE, D, DFE, (bf16*)WSP(WS_WMGU) + (size_t)e * 2 * DFE * D, D, 0, 1, base, gw, NGW, scr, lane);
                    tr_matrix(INP(20) + (size_t)e * D * DFE, D, DFE, (bf16*)WSP(WS_WMGU) + (size_t)e * 2 * DFE * D, D, 0, 2, base, gw, NGW, scr, lane);
                    tr_matrix(INP(21) + (size_t)e * DFE * D, DFE, D, (bf16*)WSP(WS_WMD) + (size_t)e * D * DFE, DFE, 0, 0, base, gw, NGW, scr, lane);
                }
            }
            GRID_BAR(); STAMP(9);
            LAS int* TP = (LAS int*)(lds + LDSCTL_OFF + 1024);
            if (threadIdx.x == 0) { int acc_t = 0; unsigned* cnt = (unsigned*)WSP(WS_CTL) + CW_CNT;
                for (int e = 0; e < NE; ++e) { TP[e] = acc_t; acc_t += ((int)xb_ld(cnt + 64 * e) + 255) >> 8; }
                TP[NE] = acc_t; }
            __syncthreads();
            {
                PHASE_IDS();
                u32x4* ROUTE = (u32x4*)WSP(WS_ROUTE); const bf16* HX = (const bf16*)WSP(WS_HX); bf16* XY = (bf16*)WSP(WS_XY);
                u32x4 rn = ROUTE[gw < ML ? gw : 0]; u32x4 hn0 = *(const u32x4*)(HX + (size_t)(gw < ML ? gw : 0) * D + 8 * lane), hn1 = *(const u32x4*)(HX + (size_t)(gw < ML ? gw : 0) * D + 512 + 8 * lane);
                for (int row = gw; row < ML; row += NGW) { const u32x4 r = rn; const u32x4 h0 = hn0, h1 = hn1;
                    if (row + NGW < ML) { rn = ROUTE[row + NGW]; hn0 = *(const u32x4*)(HX + (size_t)(row + NGW) * D + 8 * lane); hn1 = *(const u32x4*)(HX + (size_t)(row + NGW) * D + 512 + 8 * lane); }
                    const unsigned p0 = (unsigned)(TP[r.x & 255u] * 256) + (r.x >> 8), p1 = (unsigned)(TP[r.y & 255u] * 256) + (r.y >> 8);
                    *(u32x4*)(XY + (size_t)p0 * D + 8 * lane) = h0; *(u32x4*)(XY + (size_t)p0 * D + 512 + 8 * lane) = h1;
                    *(u32x4*)(XY + (size_t)p1 * D + 8 * lane) = h0; *(u32x4*)(XY + (size_t)p1 * D + 512 + 8 * lane) = h1;
                    if (lane == 0) { u32x4 r2; r2.x = p0; r2.y = p1; r2.z = r.z; r2.w = r.w; ROUTE[row] = r2; } }
            }
            GRID_BAR(); STAMP(10);
            const int ntiles = __builtin_amdgcn_readfirstlane(TP[NE]);
#pragma unroll 1
            for (int t0 = 0; t0 < ntiles; t0 += MOE_CHUNK) { const int ntc = min(MOE_CHUNK, ntiles - t0);
                { pg8::Gemm g{D, D}; pg8::SchedMoeUp S;
#pragma unroll
                  for (int e = 0; e <= NE; ++e) S.T.pre[e] = __builtin_amdgcn_readfirstlane(TP[e]);
                  S.t0 = t0; S.ntc = ntc; S.G = fresh_s((int)gridDim.x); S.c = fresh_s((int)blockIdx.x); S.X = (const char*)WSP(WS_XY); S.W = (const char*)WSP(WS_WMGU);
                  pg8::EpiSwiglu E{(bf16*)WSP(WS_H), DFE};
                  pg8::gemm_phase<pg8::EpiSwiglu, pg8::SchedMoeUp>(lds, g, S, E);
                }
                GRID_BAR(); STAMP(11);
                { pg8::Gemm g{DFE, DFE}; pg8::SchedMoeDown S;
#pragma unroll
                  for (int e = 0; e <= NE; ++e) S.T.pre[e] = __builtin_amdgcn_readfirstlane(TP[e]);
                  const bool split = (ntc <= 8) && (t0 > 0);
                  S.t0 = t0; S.ntc = ntc; S.nsl = split ? 7 : 1; S.G = fresh_s((int)gridDim.x); S.c = fresh_s((int)blockIdx.x); S.H = (const char*)WSP(WS_H); S.W = (const char*)WSP(WS_WMD);
                  pg8::EpiBf16 E{split ? (bf16*)WSP(WS_PART) : (bf16*)WSP(WS_XY), D};
                  pg8::gemm_phase<pg8::EpiBf16, pg8::SchedMoeDown>(lds, g, S, E);
                }
                GRID_BAR(); STAMP(12);
            }
            {
            PHASE_IDS();
                const u32x4* ROUTE = (const u32x4*)WSP(WS_ROUTE); const bf16* XY = (const bf16*)WSP(WS_XY); const float* modl = (const float*)WSP(WS_MOD) + (size_t)5 * NMOD; float* OUT = OUTP; const float* fg = INP(22);
                const int ntl = __builtin_amdgcn_readfirstlane(TP[NE]), nrem = ntl & 63; const bool splitc = (nrem >= 1) && (nrem <= 8) && (ntl > 64); const unsigned rem_base = splitc ? (unsigned)(ntl - nrem) * 256u : 0xffffffffu;
                const bf16* PY = (const bf16*)WSP(WS_PART);
                LAS float* G2T = (LAS float*)lds; LAS float* FGT = (LAS float*)(lds + 16384);
                for (int i = tid; i < 4 * D; i += NWAVES * 64) G2T[i] = modl[(size_t)(i >> 10) * NMOD + 5 * D + (i & 1023)];
                for (int i = tid; i < D; i += NWAVES * 64) FGT[i] = fg[i];
                __syncthreads();
                u32x4 rn = ROUTE[gw < ML ? gw : 0];
                for (int row = gw; row < ML; row += NGW) { const u32x4 r = rn; if (row + NGW < ML) rn = ROUTE[row + NGW];
                    const float w0 = __uint_as_float(r.z), w1 = __uint_as_float(r.w); const int v = row >> 13;
                    LAS const float* g2 = G2T + v * D; float* xr = OUT + (size_t)row * D; float val[16]; float ss = 0.f;
#pragma unroll
                    for (int jj = 0; jj < 2; ++jj) { const int o = 8 * lane + 512 * jj;
                        float a0[8], a1[8];
                        if (r.x < rem_base && r.y < rem_base) {
                            const u32x4 y0 = *(const u32x4*)(XY + (size_t)r.x * D + o), y1 = *(const u32x4*)(XY + (size_t)r.y * D + o);
                            a0[0] = bflo(y0.x); a0[1] = bfhi(y0.x); a0[2] = bflo(y0.y); a0[3] = bfhi(y0.y); a0[4] = bflo(y0.z); a0[5] = bfhi(y0.z); a0[6] = bflo(y0.w); a0[7] = bfhi(y0.w);
                            a1[0] = bflo(y1.x); a1[1] = bfhi(y1.x); a1[2] = bflo(y1.y); a1[3] = bfhi(y1.y); a1[4] = bflo(y1.z); a1[5] = bfhi(y1.z); a1[6] = bflo(y1.w); a1[7] = bfhi(y1.w);
                        } else {
#pragma unroll
                            for (int t = 0; t < 2; ++t) { const unsigned p = t ? r.y : r.x; float* aa = t ? a1 : a0;
                                if (p >= rem_base) {
#pragma unroll
                                    for (int j = 0; j < 8; ++j) aa[j] = 0.f;
#pragma unroll 1
                                    for (int sl = 0; sl < 7; ++sl) { const u32x4 y = *(const u32x4*)(PY + ((size_t)sl * 2048 + (p - rem_base)) * D + o);
                                        aa[0] += bflo(y.x); aa[1] += bfhi(y.x); aa[2] += bflo(y.y); aa[3] += bfhi(y.y); aa[4] += bflo(y.z); aa[5] += bfhi(y.z); aa[6] += bflo(y.w); aa[7] += bfhi(y.w); }
                                } else { const u32x4 y = *(const u32x4*)(XY + (size_t)p * D + o);
                                    aa[0] = bflo(y.x); aa[1] = bfhi(y.x); aa[2] = bflo(y.y); aa[3] = bfhi(y.y); aa[4] = bflo(y.z); aa[5] = bfhi(y.z); aa[6] = bflo(y.w); aa[7] = bfhi(y.w); } }
                        }
                        const f32x4 xa = *(const f32x4*)(xr + o), xb = *(const f32x4*)(xr + o + 4), ga = *(const LAS f32x4*)(g2 + o), gb = *(const LAS f32x4*)(g2 + o + 4);
                        const float xv[8] = {xa.x, xa.y, xa.z, xa.w, xb.x, xb.y, xb.z, xb.w}, gv[8] = {ga.x, ga.y, ga.z, ga.w, gb.x, gb.y, gb.z, gb.w};
#pragma unroll
                        for (int j = 0; j < 8; ++j) { const float t = xv[j] + gv[j] * (w0 * a0[j] + w1 * a1[j]); val[8 * jj + j] = t; ss += t * t; } }
                    const float rstd = 1.0f / sqrtf(wave_sum(ss, lane) * (1.f / D) + EPS);
#pragma unroll
                    for (int jj = 0; jj < 2; ++jj) { const int o = 8 * lane + 512 * jj; const f32x4 fa = *(const LAS f32x4*)(FGT + o), fb = *(const LAS f32x4*)(FGT + o + 4);
                        *(f32x4*)(xr + o) = (f32x4){val[8 * jj] * rstd * fa.x, val[8 * jj + 1] * rstd * fa.y, val[8 * jj + 2] * rstd * fa.z, val[8 * jj + 3] * rstd * fa.w};
                        *(f32x4*)(xr + o + 4) = (f32x4){val[8 * jj + 4] * rstd * fb.x, val[8 * jj + 5] * rstd * fb.y, val[8 * jj + 6] * rstd * fb.z, val[8 * jj + 7] * rstd * fb.w}; }
                }
            }
#ifdef PROBE_GA
            STAMP(13);
            if (blockIdx.x == 0 && threadIdx.x == 0) { const unsigned dl = TSW[PROBE_GA] * PROBE_AMP; const unsigned long long t0 = __builtin_amdgcn_s_memrealtime();
                while ((unsigned)(__builtin_amdgcn_s_memrealtime() - t0) < dl) __builtin_amdgcn_s_sleep(8); }
#endif
        }
    }
}

extern "C" void kernel_launch(void* const* d_in, const int* in_sizes, int n_in, void* d_out, int out_size, void* d_ws, size_t ws_size, hipStream_t stream) {
    static int grid = 0;
    if (grid == 0) {
        if (n_in != 23 || out_size != ML * D || ws_size < WS_END) { fprintf(stderr, "kernel_launch: unexpected problem (n_in %d, out %d, ws %zu)\n", n_in, out_size, ws_size); grid = -1; return; }
        int dev = 0, cus = 0, per_cu = 0;
        if (hipGetDevice(&dev) != hipSuccess || hipDeviceGetAttribute(&cus, hipDeviceAttributeMultiprocessorCount, dev) != hipSuccess) { grid = -1; return; }
        if (hipFuncSetAttribute((const void*)fwd_kernel, hipFuncAttributeMaxDynamicSharedMemorySize, LDS_BYTES) != hipSuccess) { fprintf(stderr, "kernel_launch: hipFuncSetAttribute failed\n"); grid = -1; return; }
        if (hipOccupancyMaxActiveBlocksPerMultiprocessor(&per_cu, (const void*)fwd_kernel, NWAVES * 64, LDS_BYTES) != hipSuccess || per_cu < 1) { fprintf(stderr, "kernel_launch: occupancy query says %d\n", per_cu); }
        (void)hipGetLastError();
        grid = cus;
        if (grid != 256) { fprintf(stderr, "kernel_launch: built for 256 CUs, device has %d\n", cus); grid = -1; return; }
    }
    if (grid < 0) return;
    if (hipMemsetAsync((char*)d_ws + WS_CTL, 0, CTL_ZERO_BYTES, stream) != hipSuccess) return;
    Args a{};
    for (int i = 0; i < 23; ++i) a.in[i] = (const float*)d_in[i];
    a.out = (float*)d_out; a.ws = (unsigned char*)d_ws;
    hipLaunchKernelGGL(fwd_kernel, dim3(grid), dim3(NWAVES * 64), LDS_BYTES, stream, a);
}
```

```cpp
#include <hip/hip_runtime.h>
#include <cstdio>
#include <cstdint>

#define LAS __attribute__((address_space(3)))
#define GAS __attribute__((address_space(1)))
typedef unsigned short bf16;
typedef short bf16x8 __attribute__((ext_vector_type(8)));
typedef float f32x4 __attribute__((ext_vector_type(4)));
typedef float f32x2 __attribute__((ext_vector_type(2)));
typedef unsigned u32x4 __attribute__((ext_vector_type(4)));
typedef unsigned u32x2 __attribute__((ext_vector_type(2)));
typedef __bf16 bf16x2_t __attribute__((ext_vector_type(2)));

constexpr int D = 1024, BATCH = 4, SEQ = 8192, CTXL = 256;
constexpr int ML = BATCH * SEQ, MC = BATCH * CTXL, MT = ML + MC;
constexpr int ZP = 2688;
constexpr int PW = 5632, Q_OFF = 256, K_OFF = 768, V_OFF = 1280, U_OFF = 1792, B_OFF = 2048, C_OFF = 2304, G_OFF = 2560;
constexpr int DFF = 2816, DFE = 3584, NE = 8;
constexpr int VT_LD = SEQ + CTXL + 128;
constexpr int NMOD = 6 * D;
constexpr float EPS = 1e-6f;
constexpr int MOE_CHUNK = 64;

constexpr size_t MiB = 1u << 20;
constexpr size_t WS_CTL = 0, CTL_ZERO_BYTES = 1 * MiB;
constexpr size_t WS_MOD = 1 * MiB;
constexpr size_t WS_ROUTE = 1 * MiB + 256 * 1024;
constexpr size_t WS_TAB = 1 * MiB + 768 * 1024;
constexpr size_t WS_CP = 2 * MiB;
constexpr size_t WS_XC = 4 * MiB;
constexpr size_t WS_WIN = 8 * MiB;
constexpr size_t WS_WCAT = 30 * MiB;
constexpr size_t WS_WOUT = 34 * MiB;
constexpr size_t WS_WGU0 = 38 * MiB;
constexpr size_t WS_WD0 = 49 * MiB;
constexpr size_t WS_HX = 55 * MiB;
constexpr size_t WS_Z = 121 * MiB;
constexpr size_t WS_GQ = 295 * MiB;
constexpr size_t WS_VT = 394 * MiB;
constexpr size_t WS_R = 428 * MiB;
constexpr size_t WS_PART = 460 * MiB;
constexpr size_t WS_XB = 533 * MiB;
constexpr size_t WS_END = 597 * MiB;
constexpr size_t WS_G = WS_Z;
constexpr size_t WS_WMGU = 121 * MiB;
constexpr size_t WS_WMD = 233 * MiB;
constexpr size_t WS_H = 289 * MiB;
constexpr size_t WS_XY = 401 * MiB;
static_assert(WS_Z + (size_t)MT * ZP * 2 <= WS_GQ && WS_GQ + (size_t)MT * 3072 <= WS_VT && WS_VT + (size_t)BATCH * 8 * 64 * VT_LD * 2 <= WS_R && WS_R + (size_t)32 * MiB <= WS_PART && WS_PART + (size_t)11 * MC * D * 4 <= WS_XB && WS_XY + (size_t)67584 * 1024 * 2 <= WS_XB && WS_XB + (size_t)ML * D * 2 <= WS_END && WS_H + (size_t)16384 * 3584 * 2 <= WS_XY && WS_G + (size_t)MT * DFF * 2 <= WS_VT, "ws map");
constexpr int CW_TMO = 0, CW_BAR = 4096, CW_CNT = 8192;

constexpr int RING_BYTES = 131072, LDSCTL_OFF = RING_BYTES, MISC_OFF = LDSCTL_OFF + 320, LDS_BYTES = 147456;
constexpr int NWAVES = 8;

__device__ __forceinline__ int fresh_s(int v) { asm volatile("" : "+s"(v)); return v; }
__device__ __forceinline__ int fresh_tid(int wave0) { unsigned z = 0u; asm volatile("" : "+v"(z)); return wave0 * 64 + (int)__builtin_amdgcn_mbcnt_hi(~0u, __builtin_amdgcn_mbcnt_lo(~0u, z)); }
__device__ __forceinline__ unsigned pk2(float lo, float hi) { f32x2 v = {lo, hi}; bf16x2_t b = __builtin_convertvector(v, bf16x2_t); return __builtin_bit_cast(unsigned, b); }
__device__ __forceinline__ float bflo(unsigned w) { return __uint_as_float(w << 16); }
__device__ __forceinline__ float bfhi(unsigned w) { return __uint_as_float(w & 0xffff0000u); }
__device__ __forceinline__ float bf2f(bf16 b) { return __uint_as_float(((unsigned)b) << 16); }
__device__ __forceinline__ float fast_exp2(float x) { return __builtin_amdgcn_exp2f(x); }
__device__ __forceinline__ float sigmoidf_(float x) { return __builtin_amdgcn_rcpf(1.0f + __builtin_amdgcn_exp2f(-1.44269504088896f * x)); }

#ifndef RELAX_EPI
#define RELAX_EPI 0
#endif
namespace pg8 {
constexpr int BM = 256, BK = 64, HALF = 128, HTB = HALF * BK * 2, STAGE_BYTES = 8 * HTB, NXCD = 8, WGM = 8;
__host__ __device__ __forceinline__ int lds_byte(int r, int c) { const int st = (r >> 4) * 2 + (c >> 5), rr = r & 15, cc = c & 31, ob = rr * 64 + cc * 2; return st * 1024 + (ob ^ (((ob >> 9) & 1) << 5)); }
__host__ __device__ __forceinline__ void stage_rc(int b, int& R, int& C) { const int st = b / 1024, sb = b % 1024, swz = sb ^ (((sb >> 9) & 1) << 5); R = (st >> 1) * 16 + swz / 64; C = (st & 1) * 32 + (swz % 64) / 2; }
__host__ __device__ __forceinline__ int perm32(int rho) { const int n = rho >> 4, i = rho & 15; return 8 * (i >> 2) + 4 * n + (i & 3); }

struct Unit { int pm, pn; const char* A; const char* B; int nt; int aux; };
struct Gemm { int lda, ldb; };

__device__ __forceinline__ bool tile_map(long L, int nM, int nN, int& pm, int& pn) {
    const int nwg = nM * nN; if (L >= nwg) return false;
    int wgid = (int)L; { const int q = nwg / NXCD, r = nwg % NXCD, xcd = wgid % NXCD, off = wgid / NXCD; wgid = (xcd < r ? xcd * (q + 1) : r * (q + 1) + (xcd - r) * q) + off; }
    const int nig = WGM * nN, gid = wgid / nig, fm = gid * WGM, gsz = (nM - fm) < WGM ? (nM - fm) : WGM;
    pm = fm + ((wgid % nig) % gsz); pn = (wgid % nig) / gsz; return true;
}

template <class Epi, class Sched, bool ALIGN_EPI = true, bool SP2 = true>
__device__ __forceinline__ void gemm_phase(LAS unsigned char* lds, const Gemm g, const Sched& S, const Epi& E, int wave0) {
    const int tid = fresh_tid(wave0), wid = __builtin_amdgcn_readfirstlane(tid >> 6), lane = tid & 63, wr = wid >> 2, wc = wid & 3, fr = lane & 15, fq = lane >> 4;
    unsigned voffA[2], voffB[2];
#pragma unroll
    for (int i = 0; i < 2; ++i) { int R, C; stage_rc(tid * 16 + i * 8192, R, C); const int Rb = Epi::PERM ? ((R & ~31) + perm32(R & 31)) : R;
        voffA[i] = (unsigned)(R * g.lda + C) * 2u; voffB[i] = (unsigned)(Rb * g.ldb + C) * 2u; }
    const size_t kstep = (size_t)(BK * 2);
    const size_t hstepA = (size_t)HALF * g.lda * 2, hstepB = (size_t)HALF * g.ldb * 2;
    const unsigned ldsw = (unsigned)wid * 1024u;
    const int aoff = lds_byte(wr * 64 + fr, fq * 8), boff = lds_byte(wc * 32 + fr, fq * 8);
#define PG8_SA(b, h) (((b) * 2 + (h)) * HTB)
#define PG8_SB(b, h) ((4 + (b) * 2 + (h)) * HTB)
#define PG8_STAGE(bufoff, gbase, voff) do { _Pragma("unroll") for (int _i = 0; _i < 2; ++_i) \
        __builtin_amdgcn_global_load_lds((const unsigned*)((const char*)(gbase) + (voff)[_i]), (LAS unsigned*)(lds + (bufoff) + ldsw + _i * 8192), 16, 0, 0); } while (0)
#define PG8_LDA(dst, b, h) do { _Pragma("unroll") for (int m = 0; m < 4; ++m) _Pragma("unroll") for (int k = 0; k < 2; ++k) dst[m][k] = *(const LAS bf16x8*)(lds + PG8_SA(b, h) + aoff + m * 2048 + k * 1024); } while (0)
#define PG8_LDB(dst, b, h) do { _Pragma("unroll") for (int n = 0; n < 2; ++n) _Pragma("unroll") for (int k = 0; k < 2; ++k) dst[n][k] = *(const LAS bf16x8*)(lds + PG8_SB(b, h) + boff + n * 2048 + k * 1024); } while (0)
#define PG8_MMA(ai, bj, At, Bt) do { __builtin_amdgcn_s_setprio(1); _Pragma("unroll") for (int m = 0; m < 4; ++m) _Pragma("unroll") for (int n = 0; n < 2; ++n) _Pragma("unroll") for (int k = 0; k < 2; ++k) \
        acc[ai][bj][m][n] = __builtin_amdgcn_mfma_f32_16x16x32_bf16(Bt[n][k], At[m][k], acc[ai][bj][m][n], 0, 0, 0); __builtin_amdgcn_s_setprio(0); } while (0)
#define PG8_WAIT_V(n) asm volatile("s_waitcnt vmcnt(" #n ")" ::: "memory")
#define PG8_WAIT_L(n) asm volatile("s_waitcnt lgkmcnt(" #n ")" ::: "memory")
#define PG8_WAIT_VX(strict_) do { if constexpr (Epi::NST == 8) asm volatile("s_cmp_eq_u32 %0, 0\n\ts_cbranch_scc1 .Lrx_%=\n\ts_waitcnt vmcnt(8)\n.Lrx_%=:\n\ts_waitcnt vmcnt(16)" :: "s"(strict_) : "memory", "scc"); \
        else if constexpr (Epi::NST == 16) asm volatile("s_cmp_eq_u32 %0, 0\n\ts_cbranch_scc1 .Lrx_%=\n\ts_waitcnt vmcnt(8)\n.Lrx_%=:\n\ts_waitcnt vmcnt(24)" :: "s"(strict_) : "memory", "scc"); \
        else asm volatile("s_waitcnt vmcnt(8)" ::: "memory"); } while (0)
#define PG8_BAR __builtin_amdgcn_s_barrier()
#define PG8_SCHED __builtin_amdgcn_sched_barrier(0)
    Unit cur, nxt; int ui = 0;
    if (!S.next(0, cur)) return;
    f32x4 acc[2][2][4][2];
#pragma unroll
    for (int a = 0; a < 2; ++a)
#pragma unroll
        for (int b = 0; b < 2; ++b)
#pragma unroll
            for (int m = 0; m < 4; ++m)
#pragma unroll
                for (int n = 0; n < 2; ++n) acc[a][b][m][n] = (f32x4){0.f, 0.f, 0.f, 0.f};
    bf16x8 At[4][2], B0[2][2], B1[2][2];
    const char* cA = cur.A; const char* cB = cur.B;
    if constexpr (SP2) {
        PG8_STAGE(PG8_SB(0, 0), cB, voffB); PG8_STAGE(PG8_SB(0, 1), cB + hstepB, voffB); PG8_STAGE(PG8_SA(0, 0), cA, voffA); PG8_STAGE(PG8_SA(0, 1), cA + hstepA, voffA);
        if (wr == 1) PG8_BAR;
        PG8_WAIT_V(2); PG8_BAR;
        PG8_STAGE(PG8_SB(1, 0), cB + kstep, voffB); PG8_STAGE(PG8_SA(1, 0), cA + kstep, voffA); PG8_STAGE(PG8_SB(1, 1), cB + hstepB + kstep, voffB);
        PG8_WAIT_V(6); PG8_BAR;
    } else {
        PG8_STAGE(PG8_SB(0, 0), cB, voffB); PG8_STAGE(PG8_SA(0, 0), cA, voffA); PG8_STAGE(PG8_SB(0, 1), cB + hstepB, voffB); PG8_STAGE(PG8_SA(0, 1), cA + hstepA, voffA);
        if (wr == 1) PG8_BAR;
        PG8_WAIT_V(4); PG8_BAR;
        PG8_STAGE(PG8_SB(1, 0), cB + kstep, voffB); PG8_STAGE(PG8_SA(1, 0), cA + kstep, voffA); PG8_STAGE(PG8_SB(1, 1), cB + hstepB + kstep, voffB);
        PG8_WAIT_V(6); PG8_BAR;
    }
    for (;;) {
        const bool has_next = S.next(ui + 1, nxt);
        const char* nA = has_next ? nxt.A : cA; const char* nB = has_next ? nxt.B : cB;
        const int nt = cur.nt;
#define PG8_TRIP(tt, WA, WB) do { const bool last = ((tt) == nt - 2); PG8_SCHED; \
            const char* a1 = cA + (size_t)((tt) + 1) * kstep; \
            const char* a2 = last ? nA : cA + (size_t)((tt) + 2) * kstep; const char* b2 = last ? nB : cB + (size_t)((tt) + 2) * kstep; \
            const char* a3 = a2 + kstep; const char* b3 = b2 + kstep; \
            PG8_LDB(B0, 0, 0); PG8_LDB(B1, 0, 1); PG8_SCHED; PG8_LDA(At, 0, 0); PG8_STAGE(PG8_SA(1, 1), a1 + hstepA, voffA); \
            WA; PG8_WAIT_L(0); PG8_BAR; PG8_MMA(0, 0, At, B0); PG8_MMA(0, 1, At, B1); PG8_BAR; PG8_SCHED; \
            PG8_LDA(At, 0, 1); PG8_STAGE(PG8_SB(0, 0), b2, voffB); PG8_STAGE(PG8_SB(0, 1), b2 + hstepB, voffB); PG8_STAGE(PG8_SA(0, 0), a2, voffA); \
            WB; PG8_WAIT_L(0); PG8_BAR; PG8_MMA(1, 0, At, B0); PG8_MMA(1, 1, At, B1); PG8_BAR; PG8_SCHED; \
            PG8_LDB(B0, 1, 0); PG8_LDB(B1, 1, 1); PG8_SCHED; PG8_LDA(At, 1, 0); PG8_STAGE(PG8_SA(0, 1), a2 + hstepA, voffA); \
            PG8_WAIT_V(8); PG8_WAIT_L(0); PG8_BAR; PG8_MMA(0, 0, At, B0); PG8_MMA(0, 1, At, B1); PG8_BAR; PG8_SCHED; \
            PG8_LDA(At, 1, 1); PG8_STAGE(PG8_SB(1, 0), b3, voffB); PG8_STAGE(PG8_SB(1, 1), b3 + hstepB, voffB); PG8_STAGE(PG8_SA(1, 0), a3, voffA); \
            PG8_WAIT_V(8); PG8_WAIT_L(0); PG8_BAR; PG8_MMA(1, 0, At, B0); PG8_MMA(1, 1, At, B1); PG8_BAR; PG8_SCHED; } while (0)
        for (int t = 0; t < nt; t += 2) { const int strict = __builtin_amdgcn_readfirstlane((RELAX_EPI && Epi::NST > 0 && t == 0 && ui > 0) ? 0 : 1);
            PG8_TRIP(t, PG8_WAIT_VX(strict), PG8_WAIT_VX(strict)); }
#undef PG8_TRIP
        if constexpr (ALIGN_EPI) { if (wr == 0) PG8_BAR; }
        E(acc, cur, wr, wc, fr, fq);
        if (!has_next) break;
        if (E.zero_after(cur)) {
#pragma unroll
            for (int a = 0; a < 2; ++a)
#pragma unroll
                for (int b = 0; b < 2; ++b)
#pragma unroll
                    for (int m = 0; m < 4; ++m)
#pragma unroll
                        for (int n = 0; n < 2; ++n) acc[a][b][m][n] = (f32x4){0.f, 0.f, 0.f, 0.f};
        }
        cur = nxt; cA = nA; cB = nB; ++ui;
        if constexpr (ALIGN_EPI) { if (wr == 1) PG8_BAR; }
    }
    PG8_WAIT_V(0);
    if constexpr (!ALIGN_EPI) { if (wr == 0) PG8_BAR; }
    PG8_BAR;
#undef PG8_SA
#undef PG8_SB
#undef PG8_STAGE
#undef PG8_LDA
#undef PG8_LDB
#undef PG8_MMA
#undef PG8_WAIT_V
#undef PG8_WAIT_L
#undef PG8_WAIT_VX
#undef PG8_BAR
#undef PG8_SCHED
}

struct SchedPlain {
    int nM, nN, G, c, nt; const char* A; const char* B; size_t tsA, tsB;
    __device__ __forceinline__ void init(int M, int N, int K, const bf16* A_, int lda, const bf16* B_, int ldb, int G_, int c_) {
        nM = M / BM; nN = N / BM; G = G_; c = c_; nt = K / BK; A = (const char*)A_; B = (const char*)B_; tsA = (size_t)BM * lda * 2; tsB = (size_t)BM * ldb * 2; }
    __device__ __forceinline__ bool next(int i, Unit& u) const {
        if (!tile_map((long)i * G + c, nM, nN, u.pm, u.pn)) return false;
        u.A = A + (size_t)u.pm * tsA; u.B = B + (size_t)u.pn * tsB; u.nt = nt; u.aux = 0; return true; }
};
struct SchedMerge {
    int nM, G, c; const char* Z; const char* W;
    __device__ __forceinline__ bool next(int i, Unit& u) const {
        const int ii = i / 3, br = i - 3 * ii;
        if (!tile_map((long)ii * G + c, nM, 4, u.pm, u.pn)) return false;
        const int acol = br == 0 ? 0 : (br == 1 ? Q_OFF : B_OFF), kof = br == 0 ? 0 : (br == 1 ? 256 : 768);
        u.A = Z + ((size_t)u.pm * BM * ZP + acol) * 2; u.B = W + ((size_t)u.pn * BM * D + kof) * 2; u.nt = br == 1 ? 8 : 4; u.aux = br; return true; }
};
struct MoeTiles { int pre[NE + 1]; };
__device__ __forceinline__ int moe_expert(const MoeTiles& T, int tile) { int e = 0;
#pragma unroll
    for (int j = 1; j < NE; ++j) e += (tile >= T.pre[j]) ? 1 : 0; return e; }
struct SchedMoeUp {
    MoeTiles T; int t0, ntc, G, c; const char* X; const char* W;
    __device__ __forceinline__ bool next(int i, Unit& u) const {
        int pml; if (!tile_map((long)i * G + c, ntc, 28, pml, u.pn)) return false;
        const int tile = t0 + pml, e = moe_expert(T, tile);
        u.pm = pml; u.A = X + (size_t)tile * BM * D * 2; u.B = W + ((size_t)e * 7168 + (size_t)u.pn * BM) * D * 2; u.nt = 16; u.aux = 0; return true; }
};
struct SchedMoeDown {
    MoeTiles T; int t0, ntc, nsl, G, c; const char* H; const char* W;
    __device__ __forceinline__ bool next(int i, Unit& u) const {
        const long L = (long)i * G + c; const int per = ntc * 4; if (L >= (long)per * nsl) return false;
        const int sl = (int)(L / per); int pml; tile_map(L - (long)sl * per, ntc, 4, pml, u.pn);
        const int tile = t0 + pml, e = moe_expert(T, tile), ntk = 56 / nsl;
        u.pm = (nsl == 1) ? tile : 8 * sl + pml; u.nt = ntk; u.aux = sl;
        u.A = H + (size_t)pml * BM * DFE * 2 + (size_t)sl * ntk * 128; u.B = W + ((size_t)e * D + (size_t)u.pn * BM) * DFE * 2 + (size_t)sl * ntk * 128; return true; }
};

struct EpiInProj {
    static constexpr bool PERM = true; static constexpr int NST = 16;
    bf16* Z; bf16* VT; unsigned char* GQ;
    __device__ __forceinline__ bool zero_after(const Unit&) const { return true; }
    __device__ __forceinline__ void operator()(f32x4 (&acc)[2][2][4][2], const Unit& u, int wr, int wc, int fr_, int fq_) const {
        int fr = fr_, fq = fq_; asm volatile("" : "+v"(fr), "+v"(fq));
        const int row0 = u.pm * BM + wr * 64 + fr, col0 = u.pn * BM + wc * 32 + 8 * fq;
        const int kind = (u.pn == 1 || u.pn == 2) ? 1 : ((u.pn == 5 || u.pn == 6) ? 2 : (u.pn >= 10 ? 3 : 0));
        if (kind == 2) {
#pragma unroll
            for (int ai = 0; ai < 2; ++ai)
#pragma unroll
                for (int m = 0; m < 4; ++m) { const int row = row0 + ai * HALF + m * 16;
                    const int b = row < ML ? (row >> 13) : ((row - ML) >> 8), t = row < ML ? (row & 8191) : (SEQ + ((row - ML) & 255));
#pragma unroll
                    for (int bj = 0; bj < 2; ++bj)
#pragma unroll
                        for (int n = 0; n < 2; ++n)
#pragma unroll
                            for (int j = 0; j < 4; ++j) { const int vc = col0 + bj * HALF + 4 * n + j - V_OFF;
                                VT[((size_t)(b * 512 + vc)) * VT_LD + t] = (bf16)(pk2(acc[ai][bj][m][n][j], 0.f) & 0xffffu); } }
            return;
        }
        if (kind == 3) {
            unsigned char* gq_tile = GQ + ((size_t)(u.pm * 12 + (u.pn - 10)) * 8 + (wr * 4 + wc)) * 8192 + (fq * 16 + fr) * 8;
#pragma unroll
            for (int ai = 0; ai < 2; ++ai)
#pragma unroll
                for (int m = 0; m < 4; ++m) { unsigned char* rowp = gq_tile + ((ai * 4 + m) * 2) * 512;
#pragma unroll
                    for (int bj = 0; bj < 2; ++bj) { u32x2 w; w.x = 0u; w.y = 0u;
#pragma unroll
                        for (int j = 0; j < 4; ++j) { w.x |= (unsigned)(sigmoidf_(acc[ai][bj][m][0][j]) * 255.0f + 0.5f) << (8 * j); w.y |= (unsigned)(sigmoidf_(acc[ai][bj][m][1][j]) * 255.0f + 0.5f) << (8 * j); }
                        *(u32x2*)(rowp + bj * 512) = w; } }
            return;
        }
        const float qs = 0.125f * 1.44269504088896f;
#pragma unroll
        for (int ai = 0; ai < 2; ++ai)
#pragma unroll
            for (int m = 0; m < 4; ++m) { bf16* rowp = Z + (size_t)(row0 + ai * HALF + m * 16) * ZP + col0;
#pragma unroll
                for (int bj = 0; bj < 2; ++bj) { f32x4 v0 = acc[ai][bj][m][0], v1 = acc[ai][bj][m][1];
                    if (kind == 1) { v0 = v0 * qs; v1 = v1 * qs; }
                    u32x4 w; w.x = pk2(v0[0], v0[1]); w.y = pk2(v0[2], v0[3]); w.z = pk2(v1[0], v1[1]); w.w = pk2(v1[2], v1[3]);
                    *(u32x4*)(rowp + bj * HALF) = w; } }
    }
};
struct EpiMerge {
    static constexpr bool PERM = true; static constexpr int NST = 0;
    const unsigned char* GQ; bf16* O;
    __device__ __forceinline__ bool zero_after(const Unit& u) const { return u.aux == 2; }
    __device__ __forceinline__ void operator()(f32x4 (&acc)[2][2][4][2], const Unit& u, int wr, int wc, int fr_, int fq_) const {
        int fr = fr_, fq = fq_; asm volatile("" : "+v"(fr), "+v"(fq));
        const int row0 = u.pm * BM + wr * 64 + fr, col0 = u.pn * BM + wc * 32 + 8 * fq, br = u.aux;
        const unsigned char* gq_t = GQ + ((size_t)(u.pm * 12 + u.pn) * 8 + (wr * 4 + wc)) * 8192 + (fq * 16 + fr) * 8;
        u32x2 gc[16], gn[16];
#pragma unroll
        for (int i = 0; i < 16; ++i) { gc[i] = *(const u32x2*)(gq_t + (size_t)br * 4 * 65536 + i * 512); gn[i] = (br < 2) ? *(const u32x2*)(gq_t + (size_t)(br + 1) * 4 * 65536 + i * 512) : gc[i]; }
#pragma unroll
        for (int ai = 0; ai < 2; ++ai)
#pragma unroll
            for (int m = 0; m < 4; ++m) { const size_t row = (size_t)(row0 + ai * HALF + m * 16);
#pragma unroll
                for (int bj = 0; bj < 2; ++bj) { const int col = col0 + bj * HALF, i = (ai * 4 + m) * 2 + bj;
                    float f[8];
#pragma unroll
                    for (int j = 0; j < 4; ++j) { f[j] = fmaxf((float)((gc[i].x >> (8 * j)) & 255u), 0.5f); f[4 + j] = fmaxf((float)((gc[i].y >> (8 * j)) & 255u), 0.5f); }
                    if (br < 2) {
#pragma unroll
                        for (int j = 0; j < 4; ++j) { f[j] *= __builtin_amdgcn_rcpf(fmaxf((float)((gn[i].x >> (8 * j)) & 255u), 0.5f)); f[4 + j] *= __builtin_amdgcn_rcpf(fmaxf((float)((gn[i].y >> (8 * j)) & 255u), 0.5f)); } }
                    else {
#pragma unroll
                        for (int j = 0; j < 8; ++j) f[j] *= (1.0f / 255.0f); }
#pragma unroll
                    for (int j = 0; j < 4; ++j) { acc[ai][bj][m][0][j] *= f[j]; acc[ai][bj][m][1][j] *= f[4 + j]; }
                    if (br == 2) { const f32x4 v0 = acc[ai][bj][m][0], v1 = acc[ai][bj][m][1];
                        u32x4 w; w.x = pk2(v0[0], v0[1]); w.y = pk2(v0[2], v0[3]); w.z = pk2(v1[0], v1[1]); w.w = pk2(v1[2], v1[3]);
                        *(u32x4*)(O + row * D + col) = w; } } }
    }
};
struct EpiResid {
    static constexpr bool PERM = true; static constexpr int NST = 16;
    const float* xin_f; const bf16* xin_b; bf16* xout; const float* gate; float* part;
    __device__ __forceinline__ bool zero_after(const Unit&) const { return true; }
    __device__ __forceinline__ void operator()(f32x4 (&acc)[2][2][4][2], const Unit& u, int wr, int wc, int fr_, int fq_) const {
        int fr = fr_, fq = fq_; asm volatile("" : "+v"(fr), "+v"(fq));
        const int rt = u.pm * BM, col0 = u.pn * BM + wc * 32 + 8 * fq;
        const bool lat = rt < ML; const int v = lat ? (rt >> 13) : 4;
        f32x4 gv[2][2];
#pragma unroll
        for (int bj = 0; bj < 2; ++bj)
#pragma unroll
            for (int n = 0; n < 2; ++n) gv[bj][n] = *(const f32x4*)(gate + (size_t)v * NMOD + col0 + bj * HALF + 4 * n);
        if (u.aux > 0) {
            float* po = part + ((size_t)(u.aux - 1) * MC + (rt - ML)) * D;
#pragma unroll
            for (int ai = 0; ai < 2; ++ai)
#pragma unroll
                for (int m = 0; m < 4; ++m) { const size_t off = (size_t)(wr * 64 + fr + ai * HALF + m * 16) * D + col0;
#pragma unroll
                    for (int bj = 0; bj < 2; ++bj)
#pragma unroll
                        for (int n = 0; n < 2; ++n) *(f32x4*)(po + off + bj * HALF + 4 * n) = gv[bj][n] * acc[ai][bj][m][n]; }
            return;
        }
        const float* xf = xin_f ? xin_f + (size_t)rt * D : nullptr; const bf16* xb = xin_b + (size_t)rt * D; bf16* xo = xout + (size_t)rt * D;
        const unsigned lo = (unsigned)((wr * 64 + fr) * D + col0);
        if (xin_f) {
#pragma unroll
            for (int ai = 0; ai < 2; ++ai) {
                f32x4 xi[4][2][2];
#pragma unroll
                for (int m = 0; m < 4; ++m) { const unsigned off = lo + (unsigned)((ai * HALF + m * 16) * D);
#pragma unroll
                    for (int bj = 0; bj < 2; ++bj)
#pragma unroll
                        for (int n = 0; n < 2; ++n) xi[m][bj][n] = *(const f32x4*)(xf + off + bj * HALF + 4 * n); }
#pragma unroll
                for (int m = 0; m < 4; ++m) { const unsigned off = lo + (unsigned)((ai * HALF + m * 16) * D);
#pragma unroll
                    for (int bj = 0; bj < 2; ++bj) { const f32x4 v0 = xi[m][bj][0] + gv[bj][0] * acc[ai][bj][m][0], v1 = xi[m][bj][1] + gv[bj][1] * acc[ai][bj][m][1];
                        u32x4 w; w.x = pk2(v0[0], v0[1]); w.y = pk2(v0[2], v0[3]); w.z = pk2(v1[0], v1[1]); w.w = pk2(v1[2], v1[3]);
                        *(u32x4*)(xo + off + bj * HALF) = w; } }
            }
        } else {
#pragma unroll
            for (int ai = 0; ai < 2; ++ai) {
                u32x4 xi[4][2];
#pragma unroll
                for (int m = 0; m < 4; ++m) { const unsigned off = lo + (unsigned)((ai * HALF + m * 16) * D);
#pragma unroll
                    for (int bj = 0; bj < 2; ++bj) xi[m][bj] = *(const u32x4*)(xb + off + bj * HALF); }
#pragma unroll
                for (int m = 0; m < 4; ++m) { const unsigned off = lo + (unsigned)((ai * HALF + m * 16) * D);
#pragma unroll
                    for (int bj = 0; bj < 2; ++bj) { const u32x4 x = xi[m][bj];
                        const f32x4 x0 = (f32x4){bflo(x.x), bfhi(x.x), bflo(x.y), bfhi(x.y)}, x1 = (f32x4){bflo(x.z), bfhi(x.z), bflo(x.w), bfhi(x.w)};
                        const f32x4 v0 = x0 + gv[bj][0] * acc[ai][bj][m][0], v1 = x1 + gv[bj][1] * acc[ai][bj][m][1];
                        u32x4 w; w.x = pk2(v0[0], v0[1]); w.y = pk2(v0[2], v0[3]); w.z = pk2(v1[0], v1[1]); w.w = pk2(v1[2], v1[3]);
                        *(u32x4*)(xo + off + bj * HALF) = w; } }
            }
        }
    }
};
struct SchedSplitCtx {
    int G, c, ntK, do_ctx; const char* A; const char* B; size_t tsA, tsB;
    __device__ __forceinline__ bool next(int i, Unit& u) const {
        const long L = (long)i * G + c; if (L >= 512 && !do_ctx) return false;
        if (L < 512) { tile_map(L, 128, 4, u.pm, u.pn); u.A = A + (size_t)u.pm * tsA; u.B = B + (size_t)u.pn * tsB; u.nt = ntK; u.aux = 0; return true; }
        const int j = (int)(L - 512), ns = ntK >> 2;
        if (j >= 16 * ns) return false;
        const int ks = j >> 4, tile = j & 15; u.pm = 128 + (tile >> 2); u.pn = tile & 3;
        u.A = A + (size_t)u.pm * tsA + (size_t)ks * 512; u.B = B + (size_t)u.pn * tsB + (size_t)ks * 512; u.nt = 4; u.aux = 1 + ks; return true; }
};
struct EpiSwiglu {
    static constexpr bool PERM = true; static constexpr int NST = 8;
    bf16* O; int ldo;
    __device__ __forceinline__ bool zero_after(const Unit&) const { return true; }
    __device__ __forceinline__ void operator()(f32x4 (&acc)[2][2][4][2], const Unit& u, int wr, int wc, int fr_, int fq_) const {
        int fr = fr_, fq = fq_; asm volatile("" : "+v"(fr), "+v"(fq));
        const int row0 = u.pm * BM + wr * 64 + fr, col0 = u.pn * HALF + wc * 32 + 8 * fq;
#pragma unroll
        for (int ai = 0; ai < 2; ++ai)
#pragma unroll
            for (int m = 0; m < 4; ++m) { bf16* rowp = O + (size_t)(row0 + ai * HALF + m * 16) * ldo + col0;
                float o[8];
#pragma unroll
                for (int n = 0; n < 2; ++n)
#pragma unroll
                    for (int j = 0; j < 4; ++j) { const float gt = acc[ai][0][m][n][j], up = acc[ai][1][m][n][j]; o[4 * n + j] = gt * sigmoidf_(gt) * up; }
                u32x4 w; w.x = pk2(o[0], o[1]); w.y = pk2(o[2], o[3]); w.z = pk2(o[4], o[5]); w.w = pk2(o[6], o[7]);
                *(u32x4*)rowp = w; }
    }
};
struct EpiBf16 {
    static constexpr bool PERM = true; static constexpr int NST = 16;
    bf16* O; int ldo;
    __device__ __forceinline__ bool zero_after(const Unit&) const { return true; }
    __device__ __forceinline__ void operator()(f32x4 (&acc)[2][2][4][2], const Unit& u, int wr, int wc, int fr_, int fq_) const {
        int fr = fr_, fq = fq_; asm volatile("" : "+v"(fr), "+v"(fq));
        const int row0 = u.pm * BM + wr * 64 + fr, col0 = u.pn * BM + wc * 32 + 8 * fq;
#pragma unroll
        for (int ai = 0; ai < 2; ++ai)
#pragma unroll
            for (int m = 0; m < 4; ++m) { bf16* rowp = O + (size_t)(row0 + ai * HALF + m * 16) * ldo + col0;
#pragma unroll
                for (int bj = 0; bj < 2; ++bj) { const f32x4 v0 = acc[ai][bj][m][0], v1 = acc[ai][bj][m][1];
                    u32x4 w; w.x = pk2(v0[0], v0[1]); w.y = pk2(v0[2], v0[3]); w.z = pk2(v1[0], v1[1]); w.w = pk2(v1[2], v1[3]);
                    *(u32x4*)(rowp + bj * HALF) = w; } }
    }
};
}

typedef GAS unsigned gu32;
#define RLX_AGENT __ATOMIC_RELAXED, __HIP_MEMORY_SCOPE_AGENT
#define LDS_WAIT() asm volatile("s_waitcnt lgkmcnt(0)" ::: "memory")
#define VM_WAIT() asm volatile("s_waitcnt vmcnt(0)" ::: "memory")
#define MFMA16(a, b, c) __builtin_amdgcn_mfma_f32_16x16x32_bf16((a), (b), (c), 0, 0, 0)

#define XB_TMO      128
#define XB_XCNT(j)  (256  + 64 * (j))
#define XB_XSUB(j)  (1280 + 64 * (j))
#define XB_XGEN(j)  (2304 + 64 * (j))
#define XB_TOP      3328
#define XB_TOPGEN   3392
#define XCD_BAR_WORDS 3456
#define XB_SPIN_CAP (1u << 18)
__device__ __forceinline__ unsigned xb_ld(unsigned* p)              { return __hip_atomic_load(p, __ATOMIC_RELAXED, __HIP_MEMORY_SCOPE_AGENT); }
__device__ __forceinline__ unsigned xb_add(unsigned* p, unsigned v) { return __hip_atomic_fetch_add(p, v, __ATOMIC_RELAXED, __HIP_MEMORY_SCOPE_AGENT); }
__device__ __forceinline__ unsigned xb_xcc_id() { return (unsigned)__builtin_amdgcn_s_getreg((3 << 11) | 20) & 0xFu; }
#define XB_SPIN(cond, bar) do { unsigned _sp = 0; while (cond) { __builtin_amdgcn_s_sleep(1); \
    if ((++_sp & 255u) == 0u) { if (xb_ld(&(bar)[XB_TMO])) break; if (_sp > XB_SPIN_CAP) { atomicAdd(&(bar)[XB_TMO], 1u); break; } } } } while (0)
struct XcdBarrier { unsigned* bar; unsigned x; volatile LAS unsigned* st; int w0; };
__device__ __forceinline__ XcdBarrier xcd_barrier_post(unsigned* bar, volatile LAS unsigned* st, int w0) {
    XcdBarrier b; b.bar = bar; b.x = xb_xcc_id(); b.st = st; b.w0 = w0;
    if (fresh_tid(w0) == 0) (void)xb_add(&bar[XB_XCNT(b.x)], 1u);
    return b;
}
__device__ __forceinline__ void xcd_barrier_complete(unsigned* bar, unsigned x, unsigned& nloc, unsigned& nx) {
    const unsigned G = gridDim.x * gridDim.y * gridDim.z;
    unsigned sum, cnt, mine, sp = 0u;
    for (;;) {
        sum = 0u; cnt = 0u; mine = 0u;
#pragma unroll
        for (unsigned j = 0; j < 16; ++j) { const unsigned c = xb_ld(&bar[XB_XCNT(j)]); sum += c; cnt += (c > 0u) ? 1u : 0u; mine = (j == x) ? c : mine; }
        if (sum == G) break;
        __builtin_amdgcn_s_sleep(1);
        if ((++sp & 255u) == 0u) { if (xb_ld(&bar[XB_TMO])) break; if (sp > XB_SPIN_CAP) { atomicAdd(&bar[XB_TMO], 1u); break; } }
    }
    nloc = mine > 0u ? mine : 1u; nx = cnt > 0u ? cnt : 1u;
}
__device__ __forceinline__ void xcd_barrier(const XcdBarrier& b) {
    asm volatile("s_waitcnt vmcnt(0)" ::: "memory");
    __syncthreads();
    if (fresh_tid(b.w0) == 0) {
        unsigned* bar = b.bar; unsigned bx_ = b.x;
        asm volatile("" : "+s"(bar), "+s"(bx_));
        __builtin_amdgcn_s_waitcnt(0);
        unsigned nloc = b.st[0], nx = b.st[1];
        if (nloc == 0u) { xcd_barrier_complete(bar, bx_, nloc, nx); b.st[0] = nloc; b.st[1] = nx; }
        const unsigned old = xb_add(&bar[XB_XSUB(bx_)], 1u);
        const unsigned gen = old / nloc;
        if (old + 1u == (gen + 1u) * nloc) {
            __builtin_amdgcn_fence(__ATOMIC_RELEASE, "agent");
            asm volatile("s_waitcnt vmcnt(0)" ::: "memory");
            const unsigned og = xb_add(&bar[XB_TOP], 1u);
            const unsigned tg = og / nx;
            if (og + 1u == (tg + 1u) * nx) xb_add(&bar[XB_TOPGEN], 1u);
            else XB_SPIN(xb_ld(&bar[XB_TOPGEN]) == tg, bar);
            __builtin_amdgcn_fence(__ATOMIC_ACQUIRE, "agent");
            xb_add(&bar[XB_XGEN(bx_)], 1u);
            asm volatile("s_waitcnt vmcnt(0)" ::: "memory");
        } else {
            XB_SPIN(xb_ld(&bar[XB_XGEN(bx_)]) == gen, bar);
            __builtin_amdgcn_fence(__ATOMIC_ACQUIRE, "agent");
            asm volatile("s_waitcnt vmcnt(0)" ::: "memory");
        }
    }
    __syncthreads();
}

__device__ __forceinline__ float shx(float v, int o, int lane) { return __int_as_float(__builtin_amdgcn_ds_bpermute((lane ^ o) << 2, __float_as_int(v))); }
__device__ __forceinline__ float wave_sum(float v, int lane) {
#pragma unroll
    for (int o = 1; o < 64; o <<= 1) v += shx(v, o, lane);
    return v;
}

__device__ __forceinline__ void transpose_item(const float* W, int N, bf16* WT, int ldk, int dst_row0, int dst_k0, int k0, int n0, LAS float* scr, int lane) {
    f32x4 v[8];
#pragma unroll
    for (int i = 0; i < 8; ++i) v[i] = *(const f32x4*)(W + (size_t)(k0 + (lane >> 3) + 8 * i) * N + n0 + 4 * (lane & 7));
#pragma unroll
    for (int i = 0; i < 8; ++i) { LAS float* d = scr + ((lane >> 3) + 8 * i) * 33 + 4 * (lane & 7); d[0] = v[i].x; d[1] = v[i].y; d[2] = v[i].z; d[3] = v[i].w; }
    LDS_WAIT(); asm volatile("" ::: "memory");
    const int c = lane & 7;
#pragma unroll
    for (int j = 0; j < 4; ++j) { const int n = (lane >> 3) + 8 * j; const LAS float* s = scr + (8 * c) * 33 + n;
        u32x4 o; o.x = pk2(s[0 * 33], s[1 * 33]); o.y = pk2(s[2 * 33], s[3 * 33]); o.z = pk2(s[4 * 33], s[5 * 33]); o.w = pk2(s[6 * 33], s[7 * 33]);
        *(u32x4*)(WT + (size_t)(dst_row0 + n) * ldk + dst_k0 + k0 + 8 * c) = o; }
    LDS_WAIT(); asm volatile("" ::: "memory");
}
__device__ __forceinline__ void tr_matrix(const float* W, int K, int N, bf16* WT, int ldk, int dst_k0, int mode, int& base, int gw, int NGW, LAS float* scr, int lane) {
    const int nnb = N / 32, items = (K / 64) * nnb;
    const int first = (gw - base % NGW + NGW) % NGW;
    for (int it = first; it < items; it += NGW) { const int kb = it / nnb, nb = it - kb * nnb, n0 = 32 * nb;
        const int dr = mode == 0 ? n0 : (256 * (n0 >> 7) + (n0 & 127) + (mode == 2 ? 128 : 0));
        transpose_item(W, N, WT, ldk, dr, dst_k0, 64 * kb, n0, scr, lane); }
    base += items;
}

__device__ __forceinline__ void norm_tables(LAS float* A, LAS float* S, const float* g, const float* mod, int shift_off, int scale_off, int tid) {
    for (int i = tid; i < 5 * D; i += NWAVES * 64) { const int v = i >> 10, k = i & 1023; A[i] = g[k] * (1.0f + mod[(size_t)v * NMOD + scale_off + k]); S[i] = mod[(size_t)v * NMOD + shift_off + k]; }
}
template <bool BF>
__device__ __forceinline__ void norm_load2(const void* x0, const void* x1, int lane, f32x4 (&v0)[4], f32x4 (&v1)[4]) {
    if (BF) {
        u32x2 a[4], b[4];
#pragma unroll
        for (int j = 0; j < 4; ++j) { a[j] = *(const u32x2*)((const bf16*)x0 + 4 * lane + 256 * j); b[j] = *(const u32x2*)((const bf16*)x1 + 4 * lane + 256 * j); }
#pragma unroll
        for (int j = 0; j < 4; ++j) { v0[j] = (f32x4){bflo(a[j].x), bfhi(a[j].x), bflo(a[j].y), bfhi(a[j].y)}; v1[j] = (f32x4){bflo(b[j].x), bfhi(b[j].x), bflo(b[j].y), bfhi(b[j].y)}; }
    } else {
#pragma unroll
        for (int j = 0; j < 4; ++j) { v0[j] = *(const f32x4*)((const float*)x0 + 4 * lane + 256 * j); v1[j] = *(const f32x4*)((const float*)x1 + 4 * lane + 256 * j); }
    }
}
__device__ __forceinline__ void norm_finish2(const f32x4 (&v0)[4], const f32x4 (&v1)[4], LAS const float* A0, LAS const float* S0, LAS const float* A1, LAS const float* S1, bf16* o0, bf16* o1, bool st1, int lane,
                                             f32x4 (&h0)[4], f32x4 (&h1)[4]) {
    float s0 = 0.f, s1 = 0.f;
#pragma unroll
    for (int j = 0; j < 4; ++j) { s0 += (v0[j].x * v0[j].x + v0[j].y * v0[j].y) + (v0[j].z * v0[j].z + v0[j].w * v0[j].w); s1 += (v1[j].x * v1[j].x + v1[j].y * v1[j].y) + (v1[j].z * v1[j].z + v1[j].w * v1[j].w); }
#pragma unroll
    for (int o = 1; o < 64; o <<= 1) { s0 += shx(s0, o, lane); s1 += shx(s1, o, lane); }
    const float r0 = 1.0f / sqrtf(s0 * (1.f / D) + EPS), r1 = 1.0f / sqrtf(s1 * (1.f / D) + EPS);
#pragma unroll
    for (int j = 0; j < 4; ++j) { const int o = 4 * lane + 256 * j;
        h0[j] = v0[j] * r0 * *(const LAS f32x4*)(A0 + o) + *(const LAS f32x4*)(S0 + o);
        h1[j] = v1[j] * r1 * *(const LAS f32x4*)(A1 + o) + *(const LAS f32x4*)(S1 + o);
        u32x2 w; w.x = pk2(h0[j].x, h0[j].y); w.y = pk2(h0[j].z, h0[j].w); *(u32x2*)(o0 + o) = w;
        if (st1) { u32x2 w1; w1.x = pk2(h1[j].x, h1[j].y); w1.y = pk2(h1[j].z, h1[j].w); *(u32x2*)(o1 + o) = w1; } }
}
template <bool BF>
__device__ __forceinline__ void norm_rows2(const void* x0, const void* x1, LAS const float* A0, LAS const float* S0, LAS const float* A1, LAS const float* S1, bf16* o0, bf16* o1, bool st1, int lane,
                                           f32x4 (&h0)[4], f32x4 (&h1)[4]) {
    f32x4 v0[4], v1[4]; norm_load2<BF>(x0, x1, lane, v0, v1); norm_finish2(v0, v1, A0, S0, A1, S1, o0, o1, st1, lane, h0, h1);
}
template <int NA, int NB>
__device__ __forceinline__ void norm_ctx_rows(const float* xc, const float* partA, const float* partB, LAS const float* TA_, LAS const float* TS_, bf16* HX, int gw, int NGW, int lane) {
    for (int r = gw; r < MC; r += NGW) {
        f32x4 v[4], pa[NA > 0 ? NA : 1][4], pb[NB > 0 ? NB : 1][4];
#pragma unroll
        for (int j = 0; j < 4; ++j) v[j] = *(const f32x4*)(xc + (size_t)r * D + 4 * lane + 256 * j);
#pragma unroll
        for (int p = 0; p < NA; ++p)
#pragma unroll
            for (int j = 0; j < 4; ++j) pa[p][j] = *(const f32x4*)(partA + ((size_t)p * MC + r) * D + 4 * lane + 256 * j);
#pragma unroll
        for (int p = 0; p < NB; ++p)
#pragma unroll
            for (int j = 0; j < 4; ++j) pb[p][j] = *(const f32x4*)(partB + ((size_t)p * MC + r) * D + 4 * lane + 256 * j);
#pragma unroll
        for (int p = 0; p < NA; ++p)
#pragma unroll
            for (int j = 0; j < 4; ++j) v[j] += pa[p][j];
#pragma unroll
        for (int p = 0; p < NB; ++p)
#pragma unroll
            for (int j = 0; j < 4; ++j) v[j] += pb[p][j];
        f32x4 h0[4], h1[4]; norm_finish2(v, v, TA_ + 4 * D, TS_ + 4 * D, TA_ + 4 * D, TS_ + 4 * D, HX + (size_t)(ML + r) * D, HX + (size_t)(ML + r) * D, false, lane, h0, h1);
    }
}
template <bool BF>
__device__ __forceinline__ void norm_phase_rows(const void* xl, LAS const float* TA_, LAS const float* TS_, bf16* HX, int gw, int NGW, int lane) {
    constexpr int ES = BF ? 2 : 4;
    const char* xb = (const char*)xl;
    f32x4 va[4], vb[4];
    { const int row = gw, rowb = (row + NGW < ML) ? row + NGW : row;
      if (row < ML) norm_load2<BF>(xb + (size_t)row * D * ES, xb + (size_t)rowb * D * ES, lane, va, vb); }
    for (int row = gw; row < ML; row += 2 * NGW) { const int row1 = row + NGW; const bool has1 = row1 < ML; const int rowb = has1 ? row1 : row;
        const int va_ = row >> 13, vb_ = rowb >> 13;
        f32x4 na[4], nb[4]; const int nrow = row + 2 * NGW;
        if (nrow < ML) { const int nrowb = (nrow + NGW < ML) ? nrow + NGW : nrow; norm_load2<BF>(xb + (size_t)nrow * D * ES, xb + (size_t)nrowb * D * ES, lane, na, nb); }
        else {
#pragma unroll
            for (int j = 0; j < 4; ++j) { na[j] = va[j]; nb[j] = vb[j]; } }
        f32x4 ha[4], hb[4]; norm_finish2(va, vb, TA_ + va_ * D, TS_ + va_ * D, TA_ + vb_ * D, TS_ + vb_ * D, HX + (size_t)row * D, HX + (size_t)rowb * D, has1, lane, ha, hb);
#pragma unroll
        for (int j = 0; j < 4; ++j) { va[j] = na[j]; vb[j] = nb[j]; }
    }
}

template <typename T> __device__ __forceinline__ T ldg_u(const void* ubase, unsigned voff) { return *(const T*)((const char*)ubase + voff); }
#define RFL(x) __builtin_amdgcn_readfirstlane(x)
typedef __amdgpu_buffer_rsrc_t rsrc_t;
__device__ __forceinline__ float quad_max(float v) {
    { auto rr = __builtin_amdgcn_permlane16_swap(__float_as_uint(v), __float_as_uint(v), false, false); v = fmaxf(__uint_as_float(rr[0]), __uint_as_float(rr[1])); }
    { auto rr = __builtin_amdgcn_permlane32_swap(__float_as_uint(v), __float_as_uint(v), false, false); v = fmaxf(__uint_as_float(rr[0]), __uint_as_float(rr[1])); }
    return v; }
__device__ __forceinline__ float quad_sum(float v) {
    { auto rr = __builtin_amdgcn_permlane16_swap(__float_as_uint(v), __float_as_uint(v), false, false); v = __uint_as_float(rr[0]) + __uint_as_float(rr[1]); }
    { auto rr = __builtin_amdgcn_permlane32_swap(__float_as_uint(v), __float_as_uint(v), false, false); v = __uint_as_float(rr[0]) + __uint_as_float(rr[1]); }
    return v; }
__device__ __forceinline__ bf16x8 bld128(rsrc_t rs, unsigned voff, int soff) { return __builtin_bit_cast(bf16x8, __builtin_amdgcn_raw_buffer_load_b128(rs, (int)voff, soff, 0)); }
constexpr int ATT_CK = 0, ATT_CV = 36864, ATT_RP = 70656, ATT_WK = 74496, ATT_WV = 92928, ATT_END = 111360;
template <bool WINDOW>
__device__ __forceinline__ void att_step(const bf16x8 (&kf)[4], const bf16x8 (&vf)[4], const bf16x8 (&qf)[2], f32x4 (&o)[4], float& mrun, float& lrun, LAS const float* rp, const float (&mk)[2][4]) {
    f32x4 t0 = MFMA16(kf[0], qf[0], ((f32x4){0.f, 0.f, 0.f, 0.f})); t0 = MFMA16(kf[1], qf[1], t0);
    f32x4 t1 = MFMA16(kf[2], qf[0], ((f32x4){0.f, 0.f, 0.f, 0.f})); t1 = MFMA16(kf[3], qf[1], t1);
    if (WINDOW) {
#pragma unroll
        for (int j = 0; j < 4; ++j) { t0[j] = (t0[j] + rp[j]) + mk[0][j]; t1[j] = (t1[j] + rp[4 + j]) + mk[1][j]; }
    }
    float cm = fmaxf(fmaxf(fmaxf(t0[0], t0[1]), fmaxf(t0[2], t0[3])), fmaxf(fmaxf(t1[0], t1[1]), fmaxf(t1[2], t1[3])));
    cm = quad_max(cm);
    const float mnew = fmaxf(mrun, cm), alpha = fast_exp2(mrun - mnew);
    float ls = 0.f;
#pragma unroll
    for (int j = 0; j < 4; ++j) { t0[j] = fast_exp2(t0[j] - mnew); t1[j] = fast_exp2(t1[j] - mnew); ls += t0[j] + t1[j]; }
    lrun = lrun * alpha + ls; mrun = mnew;
    u32x4 pw; pw.x = pk2(t0[0], t0[1]); pw.y = pk2(t0[2], t0[3]); pw.z = pk2(t1[0], t1[1]); pw.w = pk2(t1[2], t1[3]);
    const bf16x8 pf = __builtin_bit_cast(bf16x8, pw);
#pragma unroll
    for (int dt = 0; dt < 4; ++dt) { o[dt] = o[dt] * alpha; o[dt] = MFMA16(vf[dt], pf, o[dt]); }
}
template <int NU>
__device__ __forceinline__ void att_ctx(LAS const unsigned char* lds, const bf16x8 (&qf)[4][2], f32x4 (&o)[4][4], float (&mrun)[4], float (&lrun)[4], const float (&mk)[2][4], int n, int q) {
    const unsigned kl = (unsigned)((8 * (n >> 2) + (n & 3)) * 144 + 16 * q), vl = (unsigned)(n * 528 + 16 * q);
#pragma unroll 1
    for (int st = 0; st < 8; ++st) {
        bf16x8 kf[4], vf[4];
        LAS const unsigned char* kp = lds + ATT_CK + st * (32 * 144) + kl; LAS const unsigned char* vp = lds + ATT_CV + st * 64 + vl;
        kf[0] = *(const LAS bf16x8*)kp; kf[1] = *(const LAS bf16x8*)(kp + 64); kf[2] = *(const LAS bf16x8*)(kp + 4 * 144); kf[3] = *(const LAS bf16x8*)(kp + 4 * 144 + 64);
#pragma unroll
        for (int dt = 0; dt < 4; ++dt) vf[dt] = *(const LAS bf16x8*)(vp + dt * (16 * 528));
#pragma unroll
        for (int u = 0; u < NU; ++u) att_step<false>(kf, vf, qf[u], o[u], mrun[u], lrun[u], (LAS const float*)lds, mk);
    }
}
template <bool DUMMY = false>
__device__ __forceinline__ void attn_phase(LAS unsigned char* lds, bf16* Z, const bf16* VT, const float* rpb_g  , bool do_ctx_queries, int vcu, int tid, bf16* dummy = nullptr) {
    const int lane = tid & 63, wave = RFL(tid >> 6), n = lane & 15, q = lane >> 4;
    const int bh = vcu >> 3, jj = vcu & 7, b = bh >> 3, h = bh & 7;
    const rsrc_t rsZ = __builtin_amdgcn_make_buffer_rsrc((void*)Z, (short)0, (int)((size_t)MT * ZP * 2), 0x00020000);
    const rsrc_t rsV = __builtin_amdgcn_make_buffer_rsrc((void*)VT, (short)0, (int)((size_t)BATCH * 8 * 64 * VT_LD * 2), 0x00020000);
#pragma unroll
    for (int i = 0; i < 4; ++i) { const int id = tid + 512 * i;
        { const int key = id >> 3, p = id & 7; *(LAS bf16x8*)(lds + ATT_CK + key * 144 + p * 16) = bld128(rsZ, (unsigned)((key * ZP + 8 * p) * 2), ((ML + b * CTXL) * ZP + K_OFF + h * 64) * 2); }
        { const int d = id >> 5, p = id & 31; *(LAS bf16x8*)(lds + ATT_CV + d * 528 + p * 16) = bld128(rsV, (unsigned)((d * VT_LD + 8 * p) * 2), (bh * 64 * VT_LD + SEQ) * 2); } }
    for (int i = tid; i < 15 * 64; i += 512) { const int dc = (i & 63) - 16; ((LAS float*)(lds + ATT_RP))[i] = (dc >= 0 && dc <= 30) ? rpb_g[(h * 15 + (i >> 6)) * 31 + dc] * 1.44269504088896f : 0.f; }
    __syncthreads();
    const int a = (wave & 3) * 16, par = wave >> 2, s0 = min(max(a - 8, 0), 32), qc = a + n, cs = min(max(qc - 8, 0), 48);
    float mk[2][4];
#pragma unroll
    for (int hf = 0; hf < 2; ++hf)
#pragma unroll
        for (int j = 0; j < 4; ++j) { const int kc = s0 + 8 * q + 4 * hf + j; mk[hf][j] = ((kc >= cs) && (kc < cs + 16)) ? 0.f : -INFINITY; }
    const unsigned qlane = (unsigned)(n * ZP + 8 * q) * 2u, olane = (unsigned)(n * ZP + 4 * q) * 2u;
    const unsigned wkl = (unsigned)((s0 + 8 * (n >> 2) + (n & 3)) * 144 + 16 * q), wvl = (unsigned)(n * 144 + (s0 + 8 * q) * 2);
    LAS const float* rpl = (LAS const float*)(lds + ATT_RP) + (s0 + 8 * q - qc + 31);
    const unsigned stg_k = (unsigned)(((tid >> 3) * ZP + 8 * (tid & 7)) * 2), stg_v = (unsigned)(((tid >> 3) * VT_LD + 8 * (tid & 7)) * 2);
    const unsigned stg_l = (unsigned)((tid >> 3) * 144 + (tid & 7) * 16);
#pragma unroll 1
    for (int pass = 0; pass < 2; ++pass) {
        const int r_first = 16 * jj + 8 * pass, KR0 = min(max(r_first - 4, 0), 120), nrows = min(max(r_first + 7 - 4, 0), 120) + 8 - KR0;
        bf16x8 qf[4][2]; f32x4 o[4][4]; float mrun[4], lrun[4]; int rbu[4];
#pragma unroll
        for (int u = 0; u < 4; ++u) { const int r = r_first + par + 2 * u; rbu[u] = min(max(r - 4, 0), 120);
            const int qso = ((b * SEQ + r * 64 + a) * ZP + Q_OFF + h * 64) * 2;
            qf[u][0] = bld128(rsZ, qlane, qso); qf[u][1] = bld128(rsZ, qlane, qso + 64); mrun[u] = -INFINITY; lrun[u] = 0.f;
#pragma unroll
            for (int dt = 0; dt < 4; ++dt) o[u][dt] = (f32x4){0.f, 0.f, 0.f, 0.f}; }
        const int kg0 = ((b * SEQ + KR0 * 64) * ZP + K_OFF + h * 64) * 2, vg0 = (bh * 64 * VT_LD + KR0 * 64) * 2;
        bf16x8 ka, va, kb_, vb_;
        ka = bld128(rsZ, stg_k, kg0); va = bld128(rsV, stg_v, vg0);
        kb_ = bld128(rsZ, stg_k, kg0 + 64 * ZP * 2); vb_ = bld128(rsV, stg_v, vg0 + 64 * 2);
        *(LAS bf16x8*)(lds + ATT_WK + stg_l) = ka; *(LAS bf16x8*)(lds + ATT_WV + stg_l) = va;
        __syncthreads();
#define ATT_ROW(kk_, slot_, RK, RV, NK, NV) do { const int kk = (kk_); \
            if (kk + 2 < nrows) { NK = bld128(rsZ, stg_k, kg0 + (kk + 2) * (64 * ZP * 2)); NV = bld128(rsV, stg_v, vg0 + (kk + 2) * (64 * 2)); } \
            { bf16x8 kf[4], vf[4]; LAS const unsigned char* kp = lds + ATT_WK + (slot_) * 9216 + wkl; LAS const unsigned char* vp = lds + ATT_WV + (slot_) * 9216 + wvl; \
              kf[0] = *(const LAS bf16x8*)kp; kf[1] = *(const LAS bf16x8*)(kp + 64); kf[2] = *(const LAS bf16x8*)(kp + 4 * 144); kf[3] = *(const LAS bf16x8*)(kp + 4 * 144 + 64); \
              _Pragma("unroll") for (int dt = 0; dt < 4; ++dt) vf[dt] = *(const LAS bf16x8*)(vp + dt * (16 * 144)); \
              _Pragma("unroll") for (int u = 0; u < 4; ++u) { const int krow = KR0 + kk; \
                  if (krow >= rbu[u] && krow < rbu[u] + 8) att_step<true>(kf, vf, qf[u], o[u], mrun[u], lrun[u], rpl + 64 * (krow - (r_first + par + 2 * u) + 7), mk); } } \
            if (kk + 1 < nrows) { *(LAS bf16x8*)(lds + ATT_WK + (1 - (slot_)) * 9216 + stg_l) = RK; *(LAS bf16x8*)(lds + ATT_WV + (1 - (slot_)) * 9216 + stg_l) = RV; } \
            __syncthreads(); } while (0)
#pragma unroll 1
        for (int k2 = 0; k2 < nrows; k2 += 2) {
            ATT_ROW(k2, 0, kb_, vb_, ka, va);
            if (k2 + 1 < nrows) ATT_ROW(k2 + 1, 1, ka, va, kb_, vb_);
        }
#undef ATT_ROW
        att_ctx<4>(lds, qf, o, mrun, lrun, mk, n, q);
#pragma unroll
        for (int u = 0; u < 4; ++u) { float lt = lrun[u]; lt = quad_sum(lt); const float inv = 1.0f / lt;
            const int qso = ((b * SEQ + (r_first + par + 2 * u) * 64 + a) * ZP + Q_OFF + h * 64) * 2;
#pragma unroll
            for (int dt = 0; dt < 4; ++dt) { u32x2 w; w.x = pk2(o[u][dt][0] * inv, o[u][dt][1] * inv); w.y = pk2(o[u][dt][2] * inv, o[u][dt][3] * inv);
                if (DUMMY) *(u32x2*)(dummy + ((size_t)(vcu * 8 + wave) * 16 + n) * 64 + 16 * dt + 4 * q) = w; else __builtin_amdgcn_raw_buffer_store_b64(w, rsZ, (int)olane, qso + 32 * dt, 0); } }
    }
    if (do_ctx_queries && wave < 2) {
        bf16x8 qf[4][2]; f32x4 o[4][4]; float mrun[4], lrun[4];
        const int qso = ((ML + b * CTXL + 16 * (2 * jj + wave)) * ZP + Q_OFF + h * 64) * 2;
        qf[0][0] = bld128(rsZ, qlane, qso); qf[0][1] = bld128(rsZ, qlane, qso + 64); mrun[0] = -INFINITY; lrun[0] = 0.f;
#pragma unroll
        for (int dt = 0; dt < 4; ++dt) o[0][dt] = (f32x4){0.f, 0.f, 0.f, 0.f};
        att_ctx<1>(lds, qf, o, mrun, lrun, mk, n, q);
        float lt = lrun[0]; lt = quad_sum(lt); const float inv = 1.0f / lt;
#pragma unroll
        for (int dt = 0; dt < 4; ++dt) { u32x2 w; w.x = pk2(o[0][dt][0] * inv, o[0][dt][1] * inv); w.y = pk2(o[0][dt][2] * inv, o[0][dt][3] * inv);
            if (DUMMY) *(u32x2*)(dummy + ((size_t)(vcu * 8 + wave) * 16 + n) * 64 + 16 * dt + 4 * q) = w; else __builtin_amdgcn_raw_buffer_store_b64(w, rsZ, (int)olane, qso + 32 * dt, 0); }
    }
}

__device__ __forceinline__ void f1_unit(const bf16* Z, bf16* R, LAS const unsigned char* T64, LAS const unsigned char* TA, int b_, int g_, int l2_, int cb_, int lane) {
    const int b = RFL(b_), g = RFL(g_), l2 = RFL(l2_), cb = RFL(cb_);
    const int n = lane & 15, q = lane >> 4;
    const char* ubase = (const char*)(Z + (size_t)(b * SEQ + l2) * ZP + g * 64); const unsigned ulane = (unsigned)(n * 64 * ZP + 8 * q) * 2u;
    f32x4 pr[8], pi[8];
#pragma unroll
    for (int mt = 0; mt < 8; ++mt) { pr[mt] = (f32x4){0.f, 0.f, 0.f, 0.f}; pi[mt] = (f32x4){0.f, 0.f, 0.f, 0.f}; }
#pragma unroll
    for (int ks = 0; ks < 2; ++ks) {
        const bf16x8 bre = *(const LAS bf16x8*)(T64 + ((0 * 64 + 16 * cb + n) * 64 + 32 * ks + 8 * q) * 2);
        const bf16x8 bim = *(const LAS bf16x8*)(T64 + ((1 * 64 + 16 * cb + n) * 64 + 32 * ks + 8 * q) * 2);
#pragma unroll
        for (int mt = 0; mt < 8; ++mt) {
            const bf16x8 av = ldg_u<bf16x8>(ubase + ((size_t)(16 * mt * 64) * ZP + 32 * ks) * 2, ulane);
            pr[mt] = MFMA16(av, bre, pr[mt]); pi[mt] = MFMA16(av, bim, pi[mt]); }
        __builtin_amdgcn_sched_barrier(0);
    }
    bf16x8 fr[4], fi[4], fn[4];
#pragma unroll
    for (int k2 = 0; k2 < 4; ++k2) {
        u32x4 wr_, wi_, wn_;
        wr_.x = pk2(pr[2 * k2][0], pr[2 * k2][1]); wr_.y = pk2(pr[2 * k2][2], pr[2 * k2][3]); wr_.z = pk2(pr[2 * k2 + 1][0], pr[2 * k2 + 1][1]); wr_.w = pk2(pr[2 * k2 + 1][2], pr[2 * k2 + 1][3]);
        wi_.x = pk2(pi[2 * k2][0], pi[2 * k2][1]); wi_.y = pk2(pi[2 * k2][2], pi[2 * k2][3]); wi_.z = pk2(pi[2 * k2 + 1][0], pi[2 * k2 + 1][1]); wi_.w = pk2(pi[2 * k2 + 1][2], pi[2 * k2 + 1][3]);
        wn_ = wr_ ^ 0x80008000u;
        fr[k2] = __builtin_bit_cast(bf16x8, wr_); fi[k2] = __builtin_bit_cast(bf16x8, wi_); fn[k2] = __builtin_bit_cast(bf16x8, wn_);
    }
    char* rbase = (char*)(R + (size_t)(b * 4 + g) * 128 * 64 * 128 + (size_t)l2 * 128 + 16 * cb); const unsigned rlane = (unsigned)(4 * q * 64 * 128 + n) * 2u;
#pragma unroll
    for (int mt = 0; mt < 8; ++mt) {
        f32x4 qr = (f32x4){0.f, 0.f, 0.f, 0.f}, qi = (f32x4){0.f, 0.f, 0.f, 0.f};
#pragma unroll
        for (int k2 = 0; k2 < 4; ++k2) {
            const bf16x8 ac = *(const LAS bf16x8*)(TA + (((0 * 8 + mt) * 4 + k2) * 64 + lane) * 16);
            const bf16x8 as = *(const LAS bf16x8*)(TA + (((1 * 8 + mt) * 4 + k2) * 64 + lane) * 16);
            qr = MFMA16(ac, fr[k2], qr); qr = MFMA16(as, fi[k2], qr); qi = MFMA16(ac, fi[k2], qi); qi = MFMA16(as, fn[k2], qi);
        }
#pragma unroll
        for (int j = 0; j < 4; ++j) { const int k1 = 16 * mt + 4 * q + j; const float ang = (float)((l2 * k1) & 8191) * (1.0f / 4096.0f);
            const float ct = cospif(ang), st = sinpif(ang);
            const float rr = qr[j] * ct + qi[j] * st, ri = qi[j] * ct - qr[j] * st;
            char* p = rbase + (size_t)((16 * mt + j) * 64 * 128) * 2;
            *(bf16*)(p + rlane) = (bf16)(pk2(rr, 0.f) & 0xffffu); *(bf16*)(p + 128 + rlane) = (bf16)(pk2(ri, 0.f) & 0xffffu); }
        __builtin_amdgcn_sched_barrier(0);
    }
}
__device__ __forceinline__ void f3_unit(const bf16* R, bf16* Z, LAS const unsigned char* T3F, LAS unsigned char* scr, int b, int g, int k1, int ch, int lane) {
    const int n = lane & 15, q = lane >> 4;
    const bf16* Rb = R + ((size_t)((b * 4 + g) * 128 + k1) * 64) * 128;
#pragma unroll
    for (int i = 0; i < 8; ++i) { const int p = lane + 64 * i, l2 = p >> 3, reim = (p >> 2) & 1, piece = p & 3;
        const u32x4 v = *(const u32x4*)(Rb + (l2 * 2 + reim) * 64 + 32 * ch + 8 * piece);
        *(LAS u32x4*)(scr + l2 * 144 + reim * 64 + piece * 16) = v; }
    LDS_WAIT(); asm volatile("" ::: "memory");
    bf16x8 bfr[2][4];
#pragma unroll
    for (int nt = 0; nt < 2; ++nt)
#pragma unroll
        for (int ks = 0; ks < 4; ++ks) { u32x4 w; unsigned e[8];
#pragma unroll
            for (int j = 0; j < 8; ++j) { const int l2 = 32 * (ks & 1) + 8 * q + j; e[j] = *(const LAS unsigned short*)(scr + l2 * 144 + (ks >> 1) * 64 + (16 * nt + n) * 2); }
            w.x = e[0] | (e[1] << 16); w.y = e[2] | (e[3] << 16); w.z = e[4] | (e[5] << 16); w.w = e[6] | (e[7] << 16);
            bfr[nt][ks] = __builtin_bit_cast(bf16x8, w); }
    const float sc = 0.00138106793f;
#pragma unroll
    for (int mt = 0; mt < 4; ++mt) {
        f32x4 y0 = (f32x4){0.f, 0.f, 0.f, 0.f}, y1 = (f32x4){0.f, 0.f, 0.f, 0.f};
#pragma unroll
        for (int ks = 0; ks < 4; ++ks) { const bf16x8 av = *(const LAS bf16x8*)(T3F + ((mt * 4 + ks) * 64 + lane) * 16);
            y0 = MFMA16(av, bfr[0][ks], y0); y1 = MFMA16(av, bfr[1][ks], y1); }
#pragma unroll
        for (int j = 0; j < 4; ++j) { const int k2 = 16 * mt + 4 * q + j; bf16* p = Z + (size_t)(b * SEQ + k1 + 128 * k2) * ZP + g * 64 + 32 * ch + n;
            p[0] = (bf16)(pk2(y0[j] * sc, 0.f) & 0xffffu); p[16] = (bf16)(pk2(y1[j] * sc, 0.f) & 0xffffu); }
    }
    LDS_WAIT(); asm volatile("" ::: "memory");
}

__device__ __forceinline__ void stagger(unsigned ticks) {
    const unsigned dl = ((blockIdx.x >> 3) & 7u) * ticks; const unsigned long long t0 = __builtin_amdgcn_s_memrealtime();
    while ((unsigned)(__builtin_amdgcn_s_memrealtime() - t0) < dl) __builtin_amdgcn_s_sleep(4);
}
#ifndef STAG_INPROJ
#define STAG_INPROJ 0
#endif
struct Args { const float* in[23]; float* out; unsigned char* ws; };
__device__ __forceinline__ unsigned long long pt_get(LAS const unsigned long long* PT, int i) {
    int off = i; asm volatile("" : "+v"(off));
    const unsigned long long v = PT[off];
    const unsigned lo = __builtin_amdgcn_readfirstlane((unsigned)v), hi = __builtin_amdgcn_readfirstlane((unsigned)(v >> 32));
    return ((unsigned long long)hi << 32) | lo;
}
#define INP(i) ((const float*)(const GAS float*)pt_get(PT, (i)))
#define OUTP ((float*)(GAS float*)pt_get(PT, 23))
#define WSP(off) ((unsigned char*)(GAS unsigned char*)(pt_get(PT, 24) + (unsigned long long)(off)))

#define PHASE_IDS() const int tid = fresh_tid(wave0), lane = tid & 63, wave = wave0; const int G = fresh_s((int)gridDim.x), bx = fresh_s((int)blockIdx.x); \
    const int vcu = (G % 8 == 0) ? (bx % 8) * (G / 8) + bx / 8 : bx; const int gw = vcu * NWAVES + wave, NGW = G * NWAVES; (void)tid; (void)lane; (void)wave; (void)vcu; (void)gw; (void)NGW; (void)bx
__global__ void __launch_bounds__(NWAVES * 64, 2) fwd_kernel(Args args) {
    extern __shared__ __attribute__((aligned(16))) unsigned char lds_raw[];
    LAS unsigned char* lds = (LAS unsigned char*)lds_raw;
    volatile LAS unsigned* MISC = (volatile LAS unsigned*)(lds + MISC_OFF);
    LAS unsigned long long* PT = (LAS unsigned long long*)(lds + LDSCTL_OFF + 512);
    const int wave0 = __builtin_amdgcn_readfirstlane((int)threadIdx.x >> 6);
    { const int tid = threadIdx.x;

    for (int u = tid; u < (LDS_BYTES - LDSCTL_OFF) / 4; u += NWAVES * 64) ((LAS unsigned*)(lds + LDSCTL_OFF))[u] = 0u;
    __syncthreads();
    if (tid < 23) PT[tid] = (unsigned long long)args.in[tid];
    if (tid == 23) PT[23] = (unsigned long long)args.out;
    if (tid == 24) PT[24] = (unsigned long long)args.ws;
    __syncthreads();
    }
    XcdBarrier bar = xcd_barrier_post((unsigned*)WSP(WS_CTL) + CW_BAR, MISC + 8, wave0);
#define GRID_BAR() xcd_barrier(bar)
#ifdef PROBE_GA
    LAS unsigned* TSW = (LAS unsigned*)(lds + LDSCTL_OFF + 2048);
    if (blockIdx.x == 0 && threadIdx.x == 0) TSW[32] = (unsigned)wall_clock64();
#define STAMP(g) do { if (blockIdx.x == 0 && threadIdx.x == 0) { const unsigned t_ = (unsigned)wall_clock64(); TSW[(g)] += t_ - TSW[32]; TSW[32] = t_; } } while (0)
#else
#define STAMP(g) do { } while (0)
#endif

    {
            PHASE_IDS();
        if (vcu < 192) {
            LAS float* S = (LAS float*)lds;
            LAS float* P = (LAS float*)(lds + 32768);
            { const float* c_in = INP(1); const float* cctx_in = INP(3);
              for (int i = tid; i < 5 * D; i += NWAVES * 64) { const int v = i >> 10, k = i & 1023; const float cv = v < 4 ? c_in[v * D + k] : cctx_in[k]; S[i] = cv / (1.0f + __expf(-cv)); } }
            __syncthreads();
            const int l = vcu / 96, j = (vcu % 96) * 64 + lane;
            const float* W = INP(6) + (size_t)l * D * NMOD + j;
            float a0 = 0.f, a1 = 0.f, a2 = 0.f, a3 = 0.f, a4 = 0.f;
#pragma unroll 32
            for (int kk = 0; kk < 128; ++kk) { const int k = wave * 128 + kk; const float w = W[(size_t)k * NMOD];
                a0 += S[k] * w; a1 += S[D + k] * w; a2 += S[2 * D + k] * w; a3 += S[3 * D + k] * w; a4 += S[4 * D + k] * w; }
            P[(wave * 5 + 0) * 64 + lane] = a0; P[(wave * 5 + 1) * 64 + lane] = a1; P[(wave * 5 + 2) * 64 + lane] = a2; P[(wave * 5 + 3) * 64 + lane] = a3; P[(wave * 5 + 4) * 64 + lane] = a4;
            __syncthreads();
            if (wave < 5) { float s = INP(7)[l * NMOD + j];
#pragma unroll
                for (int w8 = 0; w8 < 8; ++w8) s += P[(w8 * 5 + wave) * 64 + lane];
                ((float*)WSP(WS_MOD))[((size_t)l * 5 + wave) * NMOD + j] = s; }
        }
        { bf16* TB = (bf16*)WSP(WS_TAB);
          for (int i = vcu * 512 + tid; i < 49152; i += G * 512) { float v;
              if (i < 8192) { const int reim = i >> 12, cp = (i >> 6) & 63, c = i & 63; const float ang = (float)((c * cp) & 63) * (1.0f / 32.0f); v = reim ? -sinpif(ang) : cospif(ang); }
              else if (i < 40960) { const int ii = i - 8192, e = ii & 7, ln = (ii >> 3) & 63, k2 = (ii >> 9) & 3, mt = (ii >> 11) & 7, cs = ii >> 14;
                  const int k1 = 16 * mt + (ln & 15), qq = ln >> 4, l1 = 32 * k2 + (e < 4 ? 4 * qq + e : 16 + 4 * qq + (e - 4));
                  const float ang = (float)((k1 * l1) & 127) * (1.0f / 64.0f); v = cs ? sinpif(ang) : cospif(ang); }
              else { const int ii = i - 40960, e = ii & 7, ln = (ii >> 3) & 63, ks = (ii >> 9) & 3, mt = ii >> 11;
                  const int k2 = 16 * mt + (ln & 15), kap = 32 * ks + 8 * (ln >> 4) + e, l2 = kap & 63;
                  const float ang = (float)((k2 * l2) & 63) * (1.0f / 32.0f); v = (kap >= 64) ? sinpif(ang) : cospif(ang); }
              TB[i] = (bf16)(pk2(v, 0.f) & 0xffffu); } }
        __syncthreads();
        LAS float* scr = (LAS float*)(lds + wave * 16384);
        int base = 0;
#pragma unroll 1
        for (int l = 0; l < 2; ++l) {
            tr_matrix(INP(8) + (size_t)l * D * PW, D, PW, (bf16*)WSP(WS_WIN) + (size_t)l * PW * D, D, 0, 0, base, gw, NGW, scr, lane);
            tr_matrix(INP(11) + (size_t)l * 256 * D, 256, D, (bf16*)WSP(WS_WCAT) + (size_t)l * D * D, D, 0, 0, base, gw, NGW, scr, lane);
            tr_matrix(INP(12) + (size_t)l * 512 * D, 512, D, (bf16*)WSP(WS_WCAT) + (size_t)l * D * D, D, 256, 0, base, gw, NGW, scr, lane);
            tr_matrix(INP(13) + (size_t)l * 256 * D, 256, D, (bf16*)WSP(WS_WCAT) + (size_t)l * D * D, D, 768, 0, base, gw, NGW, scr, lane);
            tr_matrix(INP(14) + (size_t)l * D * D, D, D, (bf16*)WSP(WS_WOUT) + (size_t)l * D * D, D, 0, 0, base, gw, NGW, scr, lane);
        }
        tr_matrix(INP(15), D, DFF, (bf16*)WSP(WS_WGU0), D, 0, 1, base, gw, NGW, scr, lane);
        tr_matrix(INP(16), D, DFF, (bf16*)WSP(WS_WGU0), D, 0, 2, base, gw, NGW, scr, lane);
        tr_matrix(INP(17), DFF, D, (bf16*)WSP(WS_WD0), DFF, 0, 0, base, gw, NGW, scr, lane);
    }
    GRID_BAR(); STAMP(0);

#pragma unroll 1
    for (int l = 0; l < 2; ++l) {
        const int Mmix = (l == 0) ? MT : ML;

        {
            PHASE_IDS();
            LAS float* TA_ = (LAS float*)lds; LAS float* TS_ = (LAS float*)(lds + 20480);
            norm_tables(TA_, TS_, INP(4) + l * D, (const float*)WSP(WS_MOD) + (size_t)l * 5 * NMOD, 0, D, tid);
            __syncthreads();
            bf16* HX = (bf16*)WSP(WS_HX);
            if (l == 0) norm_phase_rows<false>(INP(0), TA_, TS_, HX, gw, NGW, lane); else norm_phase_rows<true>(WSP(WS_XB), TA_, TS_, HX, gw, NGW, lane);
            if (l == 0) norm_ctx_rows<0, 0>(INP(2), nullptr, nullptr, TA_, TS_, HX, gw, NGW, lane);
            else norm_ctx_rows<4, 11>(INP(2), (const float*)WSP(WS_R), (const float*)WSP(WS_PART), TA_, TS_, HX, gw, NGW, lane);
        }
        GRID_BAR(); STAMP(1);

        { pg8::Gemm g{D, D}; pg8::SchedPlain S; S.init(MT, PW, D, (const bf16*)WSP(WS_HX), D, (const bf16*)WSP(WS_WIN) + (size_t)l * PW * D, D, fresh_s((int)gridDim.x), fresh_s((int)blockIdx.x));
          pg8::EpiInProj E{(bf16*)WSP(WS_Z), (bf16*)WSP(WS_VT), (unsigned char*)WSP(WS_GQ)};
          if (STAG_INPROJ) stagger(STAG_INPROJ);
          pg8::gemm_phase<pg8::EpiInProj, pg8::SchedPlain>(lds, g, S, E, wave0);
        }
        GRID_BAR(); STAMP(2);

        {
            PHASE_IDS();
            LAS unsigned char* T64 = lds;
            LAS unsigned char* TA = lds + 16384;
            LAS float* C64 = (LAS float*)(lds + 120832);
            LAS float* CW = (LAS float*)(lds + 120832 + 512);
            { const u32x4* TB = (const u32x4*)WSP(WS_TAB);
#pragma unroll
              for (int i = 0; i < 10; ++i) *(LAS u32x4*)(lds + (tid + 512 * i) * 16) = TB[tid + 512 * i]; }
            if (tid < 64) { const float ang = (float)tid * (1.0f / 32.0f); C64[tid] = cospif(ang); C64[64 + tid] = sinpif(ang); }
            { const float* cw = INP(9) + l * 768; for (int i = tid; i < 768; i += NWAVES * 64) CW[i] = cw[i]; }
            __syncthreads();
            bf16* Z = (bf16*)WSP(WS_Z);
            { bf16* RB = (bf16*)WSP(WS_R);
              _Pragma("unroll 1") for (int uid = gw; uid < 4096; uid += NGW) f1_unit(Z, RB, T64, TA, uid >> 10, (uid >> 8) & 3, (uid >> 2) & 63, uid & 3, lane); }
            if (l == 0) { unsigned* CP = (unsigned*)WSP(WS_CP);
              for (int it = vcu * 512 + tid; it < MC * 256; it += G * 512) { const int cp = it & 63, gg = (it >> 6) & 3, tok = it >> 8;
                const bf16* up = Z + (size_t)(ML + tok) * ZP + gg * 64; float pr = 0.f, pi = 0.f;
#pragma unroll
                for (int c8 = 0; c8 < 8; ++c8) { const u32x4 w = *(const u32x4*)(up + 8 * c8); const float uv[8] = {bflo(w.x), bfhi(w.x), bflo(w.y), bfhi(w.y), bflo(w.z), bfhi(w.z), bflo(w.w), bfhi(w.w)};
#pragma unroll
                    for (int j = 0; j < 8; ++j) { const int idx = ((8 * c8 + j) * cp) & 63; pr += uv[j] * C64[idx]; pi -= uv[j] * C64[64 + idx]; } }
                CP[(((size_t)((tok >> 8) * 4 + gg) * 256 + (tok & 255)) * 64 + cp)] = pk2(pr, pi); } }
            for (int it = vcu * 512 + tid; it < Mmix * 32; it += G * 512) { const int row = it >> 5, ch = (it & 31) * 8;
                const bool lat = row < ML; const int pos = lat ? (row & 8191) : ((row - ML) & 255), len = lat ? SEQ : CTXL;
                bf16* zr = Z + (size_t)row * ZP; float p[3][8];
#pragma unroll
                for (int d = 0; d < 3; ++d) { const bool ok = (d == 1) || (d == 0 ? pos > 0 : pos < len - 1);
                    if (ok) { const bf16* rr = zr + (ptrdiff_t)(d - 1) * ZP; const u32x4 wu = *(const u32x4*)(rr + U_OFF + ch), wc = *(const u32x4*)(rr + C_OFF + ch);
                        p[d][0] = bflo(wu.x) * bflo(wc.x); p[d][1] = bfhi(wu.x) * bfhi(wc.x); p[d][2] = bflo(wu.y) * bflo(wc.y); p[d][3] = bfhi(wu.y) * bfhi(wc.y);
                        p[d][4] = bflo(wu.z) * bflo(wc.z); p[d][5] = bfhi(wu.z) * bfhi(wc.z); p[d][6] = bflo(wu.w) * bflo(wc.w); p[d][7] = bfhi(wu.w) * bfhi(wc.w); }
                    else {
#pragma unroll
                        for (int j = 0; j < 8; ++j) p[d][j] = 0.f; } }
                const u32x4 wb = *(const u32x4*)(zr + B_OFF + ch); const float zb[8] = {bflo(wb.x), bfhi(wb.x), bflo(wb.y), bfhi(wb.y), bflo(wb.z), bfhi(wb.z), bflo(wb.w), bfhi(wb.w)};
                float o[8];
#pragma unroll
                for (int j = 0; j < 8; ++j) o[j] = zb[j] * (CW[ch + j] * p[0][j] + CW[256 + ch + j] * p[1][j] + CW[512 + ch + j] * p[2][j]);
                u32x4 w; w.x = pk2(o[0], o[1]); w.y = pk2(o[2], o[3]); w.z = pk2(o[4], o[5]); w.w = pk2(o[6], o[7]);
                *(u32x4*)(zr + B_OFF + ch) = w; }
        }
        GRID_BAR(); STAMP(3);

        {
            PHASE_IDS();
            LAS unsigned char* T3F = lds;
            LAS float* C256 = (LAS float*)(lds + 16384);
            LAS unsigned char* scr = lds + 32768 + wave * 9216;
            { const u32x4* TB = (const u32x4*)(WSP(WS_TAB) + 81920);
#pragma unroll
              for (int i = 0; i < 2; ++i) *(LAS u32x4*)(lds + (tid + 512 * i) * 16) = TB[tid + 512 * i]; }
            if (tid < 256) { const float ang = (float)tid * (1.0f / 128.0f); C256[tid] = cospif(ang); C256[256 + tid] = sinpif(ang); }
            __syncthreads();
            bf16* Z = (bf16*)WSP(WS_Z);
            { const bf16* RB = (const bf16*)WSP(WS_R);
              _Pragma("unroll 1") for (int uid = gw; uid < 4096; uid += NGW) f3_unit(RB, Z, T3F, scr, uid >> 10, (uid >> 8) & 3, (uid >> 1) & 127, uid & 1, lane); }
            if (l == 0) { __syncthreads();
                LAS unsigned* PS = (LAS unsigned*)(lds + 32768);
                const int b = vcu >> 6, gg = (vcu >> 4) & 3, lp0 = (vcu & 15) * 16;
                const unsigned* CPs = (const unsigned*)WSP(WS_CP) + (size_t)(b * 4 + gg) * 256 * 64;
#pragma unroll
                for (int i = 0; i < 8; ++i) *(LAS u32x4*)(PS + (tid + 512 * i) * 4) = *(const u32x4*)(CPs + (tid + 512 * i) * 4);
                __syncthreads();
                const int cp = tid & 63, lpa = lp0 + (tid >> 6), lpb = lpa + 8; float ya = 0.f, yb = 0.f;
#pragma unroll 8
                for (int li = 0; li < CTXL; ++li) { const unsigned w = PS[li * 64 + cp]; const float pr = bflo(w), pi = bfhi(w); const int ia = (li * lpa) & 255, ib = (li * lpb) & 255;
                    ya += C256[ia] * pr + C256[256 + ia] * pi; yb += C256[ib] * pr + C256[256 + ib] * pi; }
                Z[(size_t)(ML + b * CTXL + lpa) * ZP + gg * 64 + cp] = (bf16)(pk2(ya * (1.0f / 128.0f), 0.f) & 0xffffu);
                Z[(size_t)(ML + b * CTXL + lpb) * ZP + gg * 64 + cp] = (bf16)(pk2(yb * (1.0f / 128.0f), 0.f) & 0xffffu); }
            __syncthreads();
            attn_phase(lds, Z, (const bf16*)WSP(WS_VT), INP(10) + (size_t)l * 8 * 465, l == 0, vcu, tid);
        }
        GRID_BAR(); STAMP(4);

        { pg8::Gemm g{ZP, D}; pg8::SchedMerge S{Mmix / 256, fresh_s((int)gridDim.x), fresh_s((int)blockIdx.x), (const char*)WSP(WS_Z), (const char*)((const bf16*)WSP(WS_WCAT) + (size_t)l * D * D)};
          pg8::EpiMerge E{(const unsigned char*)WSP(WS_GQ), (bf16*)WSP(WS_HX)};
          pg8::gemm_phase<pg8::EpiMerge, pg8::SchedMerge>(lds, g, S, E, wave0);
        }
        GRID_BAR(); STAMP(5);

        { pg8::Gemm g{D, D}; pg8::SchedSplitCtx S{fresh_s((int)gridDim.x), fresh_s((int)blockIdx.x), D / 64, l == 0 ? 1 : 0, (const char*)WSP(WS_HX), (const char*)((const bf16*)WSP(WS_WOUT) + (size_t)l * D * D), (size_t)256 * D * 2, (size_t)256 * D * 2};
          pg8::EpiResid E{(l == 0) ? INP(0) : nullptr, (const bf16*)WSP(WS_XB), (bf16*)WSP(WS_XB), (const float*)WSP(WS_MOD) + (size_t)l * 5 * NMOD + 2 * D, (float*)WSP(WS_R)};
          pg8::gemm_phase<pg8::EpiResid, pg8::SchedSplitCtx>(lds, g, S, E, wave0);
        }
        GRID_BAR(); STAMP(6);

        if (l == 0) {
            {
            PHASE_IDS();
                LAS float* TA_ = (LAS float*)lds; LAS float* TS_ = (LAS float*)(lds + 20480);
                norm_tables(TA_, TS_, INP(5), (const float*)WSP(WS_MOD), 3 * D, 4 * D, tid);
                __syncthreads();
                bf16* HX = (bf16*)WSP(WS_HX);
                norm_phase_rows<true>(WSP(WS_XB), TA_, TS_, HX, gw, NGW, lane);
                norm_ctx_rows<4, 0>(INP(2), (const float*)WSP(WS_R), nullptr, TA_, TS_, HX, gw, NGW, lane);
            }
            GRID_BAR(); STAMP(1);
            { pg8::Gemm g{D, D}; pg8::SchedPlain S; S.init(MT, 2 * DFF, D, (const bf16*)WSP(WS_HX), D, (const bf16*)WSP(WS_WGU0), D, fresh_s((int)gridDim.x), fresh_s((int)blockIdx.x));
              pg8::EpiSwiglu E{(bf16*)WSP(WS_G), DFF};
              pg8::gemm_phase<pg8::EpiSwiglu, pg8::SchedPlain>(lds, g, S, E, wave0);
            }
            GRID_BAR(); STAMP(7);
            { pg8::Gemm g{DFF, DFF}; pg8::SchedSplitCtx S{fresh_s((int)gridDim.x), fresh_s((int)blockIdx.x), DFF / 64, 1, (const char*)WSP(WS_G), (const char*)WSP(WS_WD0), (size_t)256 * DFF * 2, (size_t)256 * DFF * 2};
              pg8::EpiResid E{nullptr, (const bf16*)WSP(WS_XB), (bf16*)WSP(WS_XB), (const float*)WSP(WS_MOD) + 5 * D, (float*)WSP(WS_PART)};
              pg8::gemm_phase<pg8::EpiResid, pg8::SchedSplitCtx>(lds, g, S, E, wave0); }
            GRID_BAR(); STAMP(8);
        } else {
            {
            PHASE_IDS();
                LAS float* WR = (LAS float*)lds;
                LAS int* LC = (LAS int*)(lds + 32768);
                LAS unsigned* RT = (LAS unsigned*)(lds + 32768 + 64);
                { const float* wr = INP(18); for (int i = tid; i < D * NE; i += NWAVES * 64) WR[i] = wr[i]; }
                if (tid < 16) LC[tid] = 0;
                __syncthreads();
                const int rpw = ML / (G * NWAVES);
                {
                LAS float* TA_ = (LAS float*)(lds + 40960); LAS float* TS_ = (LAS float*)(lds + 61440);
                norm_tables(TA_, TS_, INP(5) + D, (const float*)WSP(WS_MOD) + (size_t)5 * NMOD, 3 * D, 4 * D, tid);
                __syncthreads();
                bf16* HX = (bf16*)WSP(WS_HX); const bf16* xl = (const bf16*)WSP(WS_XB);
#pragma unroll 1
                for (int i = 0; i < rpw; i += 2) { const int rl = wave * rpw + i, row = vcu * (rpw * NWAVES) + rl, v = row >> 13;
                    f32x4 hv[2][4]; norm_rows2<true>(xl + (size_t)row * D, xl + (size_t)(row + 1) * D, TA_ + v * D, TS_ + v * D, TA_ + v * D, TS_ + v * D, HX + (size_t)row * D, HX + (size_t)(row + 1) * D, true, lane, hv[0], hv[1]);
                    float lg[2][NE];
#pragma unroll
                    for (int e = 0; e < NE; ++e) { lg[0][e] = 0.f; lg[1][e] = 0.f; }
#pragma unroll
                    for (int j = 0; j < 4; ++j)
#pragma unroll
                        for (int cc = 0; cc < 4; ++cc) { const int k = 4 * lane + 256 * j + cc; const f32x4 w0 = *(const LAS f32x4*)(WR + k * 8), w1 = *(const LAS f32x4*)(WR + k * 8 + 4);
#pragma unroll
                            for (int t = 0; t < 2; ++t) { const float hvv = hv[t][j][cc];
                                lg[t][0] += hvv * w0.x; lg[t][1] += hvv * w0.y; lg[t][2] += hvv * w0.z; lg[t][3] += hvv * w0.w; lg[t][4] += hvv * w1.x; lg[t][5] += hvv * w1.y; lg[t][6] += hvv * w1.z; lg[t][7] += hvv * w1.w; } }
#pragma unroll
                    for (int o = 1; o < 64; o <<= 1)
#pragma unroll
                        for (int e = 0; e < NE; ++e) { lg[0][e] += shx(lg[0][e], o, lane); lg[1][e] += shx(lg[1][e], o, lane); }
#pragma unroll
                    for (int t = 0; t < 2; ++t) {
                        int e0 = 0; float v0 = lg[t][0];
#pragma unroll
                        for (int e = 1; e < NE; ++e) if (lg[t][e] > v0) { v0 = lg[t][e]; e0 = e; }
                        int e1 = -1; float v1 = -INFINITY;
#pragma unroll
                        for (int e = 0; e < NE; ++e) if (e != e0 && lg[t][e] > v1) { v1 = lg[t][e]; e1 = e; }
                        const float w1 = 1.0f / (1.0f + __expf(v0 - v1)), w0 = 1.0f - w1;
                        if (lane == 0) { const int s0 = __hip_atomic_fetch_add(LC + e0, 1, __ATOMIC_RELAXED, __HIP_MEMORY_SCOPE_WORKGROUP), s1 = __hip_atomic_fetch_add(LC + e1, 1, __ATOMIC_RELAXED, __HIP_MEMORY_SCOPE_WORKGROUP);
                            LAS unsigned* rt = RT + (rl + t) * 6; rt[0] = (unsigned)e0; rt[1] = (unsigned)s0; rt[2] = (unsigned)e1; rt[3] = (unsigned)s1; rt[4] = __float_as_uint(w0); rt[5] = __float_as_uint(w1); } }
                }
                }
                __syncthreads();
                if (tid < NE) LC[8 + tid] = (int)xb_add((unsigned*)WSP(WS_CTL) + CW_CNT + 64 * tid, (unsigned)LC[tid]);
                __syncthreads();
                if (tid < rpw * NWAVES) { const int row = vcu * (rpw * NWAVES) + tid; const unsigned e0 = RT[tid * 6], e1 = RT[tid * 6 + 2];
                    u32x4 r; r.x = e0 | ((unsigned)(LC[8 + e0] + (int)RT[tid * 6 + 1]) << 8); r.y = e1 | ((unsigned)(LC[8 + e1] + (int)RT[tid * 6 + 3]) << 8); r.z = RT[tid * 6 + 4]; r.w = RT[tid * 6 + 5];
                    ((u32x4*)WSP(WS_ROUTE))[row] = r; }
                __syncthreads();
                LAS float* scr = (LAS float*)(lds + wave * 16384);
                int base = 0;
#pragma unroll 1
                for (int e = 0; e < NE; ++e) {
                    tr_matrix(INP(19) + (size_t)e * D * DFE, D, DFE, (bf16*)WSP(WS_WMGU) + (size_t)e * 2 * DFE * D, D, 0, 1, base, gw, NGW, scr, lane);
                    tr_matrix(INP(20) + (size_t)e * D * DFE, D, DFE, (bf16*)WSP(WS_WMGU) + (size_t)e * 2 * DFE * D, D, 0, 2, base, gw, NGW, scr, lane);
                    tr_matrix(INP(21) + (size_t)e * DFE * D, DFE, D, (bf16*)WSP(WS_WMD) + (size_t)e * D * DFE, DFE, 0, 0, base, gw, NGW, scr, lane);
                }
            }
            GRID_BAR(); STAMP(9);
            LAS int* TP = (LAS int*)(lds + LDSCTL_OFF + 1024);
            if (fresh_tid(wave0) == 0) { int acc_t = 0; unsigned* cnt = (unsigned*)WSP(WS_CTL) + CW_CNT;
                for (int e = 0; e < NE; ++e) { TP[e] = acc_t; acc_t += ((int)xb_ld(cnt + 64 * e) + 255) >> 8; }
                TP[NE] = acc_t; }
            __syncthreads();
            {
                PHASE_IDS();
                u32x4* ROUTE = (u32x4*)WSP(WS_ROUTE); const bf16* HX = (const bf16*)WSP(WS_HX); bf16* XY = (bf16*)WSP(WS_XY);
                u32x4 rn = ROUTE[gw < ML ? gw : 0]; u32x4 hn0 = *(const u32x4*)(HX + (size_t)(gw < ML ? gw : 0) * D + 8 * lane), hn1 = *(const u32x4*)(HX + (size_t)(gw < ML ? gw : 0) * D + 512 + 8 * lane);
                for (int row = gw; row < ML; row += NGW) { const u32x4 r = rn; const u32x4 h0 = hn0, h1 = hn1;
                    if (row + NGW < ML) { rn = ROUTE[row + NGW]; hn0 = *(const u32x4*)(HX + (size_t)(row + NGW) * D + 8 * lane); hn1 = *(const u32x4*)(HX + (size_t)(row + NGW) * D + 512 + 8 * lane); }
                    const unsigned p0 = (unsigned)(TP[r.x & 255u] * 256) + (r.x >> 8), p1 = (unsigned)(TP[r.y & 255u] * 256) + (r.y >> 8);
                    *(u32x4*)(XY + (size_t)p0 * D + 8 * lane) = h0; *(u32x4*)(XY + (size_t)p0 * D + 512 + 8 * lane) = h1;
                    *(u32x4*)(XY + (size_t)p1 * D + 8 * lane) = h0; *(u32x4*)(XY + (size_t)p1 * D + 512 + 8 * lane) = h1;
                    if (lane == 0) { u32x4 r2; r2.x = p0; r2.y = p1; r2.z = r.z; r2.w = r.w; ROUTE[row] = r2; } }
            }
            GRID_BAR(); STAMP(10);
            const int ntiles = __builtin_amdgcn_readfirstlane(TP[NE]);
#pragma unroll 1
            for (int t0 = 0; t0 < ntiles; t0 += MOE_CHUNK) { const int ntc = min(MOE_CHUNK, ntiles - t0);
                { pg8::Gemm g{D, D}; pg8::SchedMoeUp S;
#pragma unroll
                  for (int e = 0; e <= NE; ++e) S.T.pre[e] = __builtin_amdgcn_readfirstlane(TP[e]);
                  S.t0 = t0; S.ntc = ntc; S.G = fresh_s((int)gridDim.x); S.c = fresh_s((int)blockIdx.x); S.X = (const char*)WSP(WS_XY); S.W = (const char*)WSP(WS_WMGU);
                  pg8::EpiSwiglu E{(bf16*)WSP(WS_H), DFE};
                  pg8::gemm_phase<pg8::EpiSwiglu, pg8::SchedMoeUp>(lds, g, S, E, wave0);
                }
                GRID_BAR(); STAMP(11);
                { pg8::Gemm g{DFE, DFE}; pg8::SchedMoeDown S;
#pragma unroll
                  for (int e = 0; e <= NE; ++e) S.T.pre[e] = __builtin_amdgcn_readfirstlane(TP[e]);
                  const bool split = (ntc <= 8) && (t0 > 0);
                  S.t0 = t0; S.ntc = ntc; S.nsl = split ? 7 : 1; S.G = fresh_s((int)gridDim.x); S.c = fresh_s((int)blockIdx.x); S.H = (const char*)WSP(WS_H); S.W = (const char*)WSP(WS_WMD);
                  pg8::EpiBf16 E{split ? (bf16*)WSP(WS_HX) : (bf16*)WSP(WS_XY), D};
                  pg8::gemm_phase<pg8::EpiBf16, pg8::SchedMoeDown>(lds, g, S, E, wave0);
                }
                GRID_BAR(); STAMP(12);
            }
            {
            PHASE_IDS();
                const u32x4* ROUTE = (const u32x4*)WSP(WS_ROUTE); const bf16* XY = (const bf16*)WSP(WS_XY); const float* modl = (const float*)WSP(WS_MOD) + (size_t)5 * NMOD; float* OUT = OUTP; const bf16* XB = (const bf16*)WSP(WS_XB); const float* fg = INP(22);
                const int ntl = __builtin_amdgcn_readfirstlane(TP[NE]), nrem = ntl & 63; const bool splitc = (nrem >= 1) && (nrem <= 8) && (ntl > 64); const unsigned rem_base = splitc ? (unsigned)(ntl - nrem) * 256u : 0xffffffffu;
                const bf16* PY = (const bf16*)WSP(WS_HX);
                LAS float* G2T = (LAS float*)lds; LAS float* FGT = (LAS float*)(lds + 16384);
                for (int i = tid; i < 4 * D; i += NWAVES * 64) G2T[i] = modl[(size_t)(i >> 10) * NMOD + 5 * D + (i & 1023)];
                for (int i = tid; i < D; i += NWAVES * 64) FGT[i] = fg[i];
                __syncthreads();
                u32x4 rn = ROUTE[gw < ML ? gw : 0];
                for (int row = gw; row < ML; row += NGW) { const u32x4 r = rn; if (row + NGW < ML) rn = ROUTE[row + NGW];
                    const float w0 = __uint_as_float(r.z), w1 = __uint_as_float(r.w); const int v = row >> 13;
                    LAS const float* g2 = G2T + v * D; float* xr = OUT + (size_t)row * D; float val[16]; float ss = 0.f;
#pragma unroll
                    for (int jj = 0; jj < 2; ++jj) { const int o = 8 * lane + 512 * jj;
                        float a0[8], a1[8];
                        if (r.x < rem_base && r.y < rem_base) {
                            const u32x4 y0 = *(const u32x4*)(XY + (size_t)r.x * D + o), y1 = *(const u32x4*)(XY + (size_t)r.y * D + o);
                            a0[0] = bflo(y0.x); a0[1] = bfhi(y0.x); a0[2] = bflo(y0.y); a0[3] = bfhi(y0.y); a0[4] = bflo(y0.z); a0[5] = bfhi(y0.z); a0[6] = bflo(y0.w); a0[7] = bfhi(y0.w);
                            a1[0] = bflo(y1.x); a1[1] = bfhi(y1.x); a1[2] = bflo(y1.y); a1[3] = bfhi(y1.y); a1[4] = bflo(y1.z); a1[5] = bfhi(y1.z); a1[6] = bflo(y1.w); a1[7] = bfhi(y1.w);
                        } else {
#pragma unroll
                            for (int t = 0; t < 2; ++t) { const unsigned p = t ? r.y : r.x; float* aa = t ? a1 : a0;
                                if (p >= rem_base) {
#pragma unroll
                                    for (int j = 0; j < 8; ++j) aa[j] = 0.f;
#pragma unroll 1
                                    for (int sl = 0; sl < 7; ++sl) { const u32x4 y = *(const u32x4*)(PY + ((size_t)sl * 2048 + (p - rem_base)) * D + o);
                                        aa[0] += bflo(y.x); aa[1] += bfhi(y.x); aa[2] += bflo(y.y); aa[3] += bfhi(y.y); aa[4] += bflo(y.z); aa[5] += bfhi(y.z); aa[6] += bflo(y.w); aa[7] += bfhi(y.w); }
                                } else { const u32x4 y = *(const u32x4*)(XY + (size_t)p * D + o);
                                    aa[0] = bflo(y.x); aa[1] = bfhi(y.x); aa[2] = bflo(y.y); aa[3] = bfhi(y.y); aa[4] = bflo(y.z); aa[5] = bfhi(y.z); aa[6] = bflo(y.w); aa[7] = bfhi(y.w); } }
                        }
                        const u32x4 xw = *(const u32x4*)(XB + (size_t)row * D + o); const f32x4 ga = *(const LAS f32x4*)(g2 + o), gb = *(const LAS f32x4*)(g2 + o + 4);
                        const float xv[8] = {bflo(xw.x), bfhi(xw.x), bflo(xw.y), bfhi(xw.y), bflo(xw.z), bfhi(xw.z), bflo(xw.w), bfhi(xw.w)}, gv[8] = {ga.x, ga.y, ga.z, ga.w, gb.x, gb.y, gb.z, gb.w};
#pragma unroll
                        for (int j = 0; j < 8; ++j) { const float t = xv[j] + gv[j] * (w0 * a0[j] + w1 * a1[j]); val[8 * jj + j] = t; ss += t * t; } }
                    const float rstd = 1.0f / sqrtf(wave_sum(ss, lane) * (1.f / D) + EPS);
#pragma unroll
                    for (int jj = 0; jj < 2; ++jj) { const int o = 8 * lane + 512 * jj; const f32x4 fa = *(const LAS f32x4*)(FGT + o), fb = *(const LAS f32x4*)(FGT + o + 4);
                        *(f32x4*)(xr + o) = (f32x4){val[8 * jj] * rstd * fa.x, val[8 * jj + 1] * rstd * fa.y, val[8 * jj + 2] * rstd * fa.z, val[8 * jj + 3] * rstd * fa.w};
                        *(f32x4*)(xr + o + 4) = (f32x4){val[8 * jj + 4] * rstd * fb.x, val[8 * jj + 5] * rstd * fb.y, val[8 * jj + 6] * rstd * fb.z, val[8 * jj + 7] * rstd * fb.w}; }
                }
            }
#ifdef PROBE_GA
            STAMP(13);
            if (blockIdx.x == 0 && threadIdx.x == 0) { const unsigned dl = TSW[PROBE_GA] * PROBE_AMP; const unsigned long long t0 = __builtin_amdgcn_s_memrealtime();
                while ((unsigned)(__builtin_amdgcn_s_memrealtime() - t0) < dl) __builtin_amdgcn_s_sleep(8); }
#endif
        }
    }
}

extern "C" void kernel_launch(void* const* d_in, const int* in_sizes, int n_in, void* d_out, int out_size, void* d_ws, size_t ws_size, hipStream_t stream) {
    static int grid = 0;
    if (grid == 0) {
        if (n_in != 23 || out_size != ML * D || ws_size < WS_END) { fprintf(stderr, "kernel_launch: unexpected problem (n_in %d, out %d, ws %zu)\n", n_in, out_size, ws_size); grid = -1; return; }
        int dev = 0, cus = 0, per_cu = 0;
        if (hipGetDevice(&dev) != hipSuccess || hipDeviceGetAttribute(&cus, hipDeviceAttributeMultiprocessorCount, dev) != hipSuccess) { grid = -1; return; }
        if (hipFuncSetAttribute((const void*)fwd_kernel, hipFuncAttributeMaxDynamicSharedMemorySize, LDS_BYTES) != hipSuccess) { fprintf(stderr, "kernel_launch: hipFuncSetAttribute failed\n"); grid = -1; return; }
        if (hipOccupancyMaxActiveBlocksPerMultiprocessor(&per_cu, (const void*)fwd_kernel, NWAVES * 64, LDS_BYTES) != hipSuccess || per_cu < 1) { fprintf(stderr, "kernel_launch: occupancy query says %d\n", per_cu); }
        (void)hipGetLastError();
        grid = cus;
        if (grid != 256) { fprintf(stderr, "kernel_launch: built for 256 CUs, device has %d\n", cus); grid = -1; return; }
    }
    if (grid < 0) return;
    if (hipMemsetAsync((char*)d_ws + WS_CTL, 0, CTL_ZERO_BYTES, stream) != hipSuccess) return;
    Args a{};
    for (int i = 0; i < 23; ++i) a.in[i] = (const float*)d_in[i];
    a.out = (float*)d_out; a.ws = (unsigned char*)d_ws;
    hipLaunchKernelGGL(fwd_kernel, dim3(grid), dim3(NWAVES * 64), LDS_BYTES, stream, a);
}
```
